# Optimizing an MI355X kernel written in HIP

```python
import jax, jax.numpy as jnp
from jax import lax
import numpy as np

D_MODEL = 1024
BATCH = 4
SEQ = 4096
DEPTH = 1

CHUNK = 64
Q_BLOCK = 128
CONV_DIM = D_MODEL
CONV_WIDTH = 3
N_HEADS = 8
QK_NOPE_DIM = 128
QK_ROPE_DIM = 64
V_HEAD_DIM = 128
QK_HEAD_DIM = QK_NOPE_DIM + QK_ROPE_DIM
Q_LORA_RANK = 384
KV_LORA_RANK = 256
ROPE_BASE = 10000.0
N_EXPERTS = 32
TOP_K = 4
D_FF_EXPERT = D_MODEL
SWIGLU_LIMIT = 7.0
SWIGLU_ALPHA = 1.702
MOE_BLOCK = 128
LN_EPS = 1e-5
RMS_EPS = 1e-6
DEEPNORM_ALPHA = (2 * DEPTH) ** 0.25
DEEPNORM_BETA = (8 * DEPTH) ** -0.25
IN_SPLITS = (CONV_DIM, CONV_DIM, CONV_DIM, Q_LORA_RANK, KV_LORA_RANK, QK_ROPE_DIM, D_MODEL, D_MODEL)
IN_DIM = sum(IN_SPLITS)

kernel_name = "hybrid_conv_mla_moe_deepnorm_block"


def layer_norm(u, g, b):
    uf = u.astype(jnp.float32)
    mu = jnp.mean(uf, axis=-1, keepdims=True)
    var = jnp.mean(jnp.square(uf - mu), axis=-1, keepdims=True)
    return ((uf - mu) * lax.rsqrt(var + LN_EPS) * g.astype(jnp.float32) + b.astype(jnp.float32)).astype(u.dtype)


def rms_norm(u, g):
    uf = u.astype(jnp.float32)
    ms = jnp.mean(jnp.square(uf), axis=-1, keepdims=True)
    return (uf * lax.rsqrt(ms + RMS_EPS) * g.astype(jnp.float32)).astype(u.dtype)


def rope_tables(positions, dtype):
    inv_freq = ROPE_BASE ** (-jnp.arange(0, QK_ROPE_DIM, 2, dtype=jnp.float32) / QK_ROPE_DIM)
    ang = positions.astype(jnp.float32)[..., None] * inv_freq
    return jnp.cos(ang).astype(dtype), jnp.sin(ang).astype(dtype)


def apply_rope(u, cos, sin):
    half = u.shape[-1] // 2
    u1, u2 = u[..., :half], u[..., half:]
    return jnp.concatenate([u1 * cos - u2 * sin, u1 * sin + u2 * cos], axis=-1)


def causal_depthwise_conv(u, w):
    c = u.shape[-1]
    return lax.conv_general_dilated(u, w[:, None, :].astype(u.dtype), window_strides=(1,),
                                    padding=[(CONV_WIDTH - 1, 0)],
                                    dimension_numbers=('NWC', 'WIO', 'NWC'),
                                    feature_group_count=c)


def chunk_causal_attention(q, k, v):
    b, s, h, dqk = q.shape
    nqb = s // Q_BLOCK
    qb = q.reshape(b, nqb, Q_BLOCK, h, dqk).transpose(1, 0, 2, 3, 4)
    key_chunk = jnp.arange(s) // CHUNK
    scale = dqk ** -0.5

    def one_block(args):
        q_blk, blk = args
        q_chunk = (blk * Q_BLOCK + jnp.arange(Q_BLOCK)) // CHUNK
        allowed = key_chunk[None, :] <= q_chunk[:, None]
        scores = jnp.einsum('bqhd,bkhd->bhqk', q_blk, k).astype(jnp.float32) * scale
        scores = jnp.where(allowed[None, None], scores, -jnp.inf)
        probs = jax.nn.softmax(scores, axis=-1).astype(v.dtype)
        return jnp.einsum('bhqk,bkhd->bqhd', probs, v)

    out = lax.map(one_block, (qb, jnp.arange(nqb)))
    return out.transpose(1, 0, 2, 3, 4).reshape(b, s, h, v.shape[-1])


def hybrid_mixer(x, cos, sin, w_in, conv_w, q_norm_g, w_uq, kv_norm_g, w_uk, w_uv,
                 w_conv_branch, w_attn_branch, w_out):
    b, s, _ = x.shape
    proj = x @ w_in
    offs = [int(o) for o in np.cumsum(IN_SPLITS)[:-1]]
    gb, gc, hc, q_lat, kv_lat, k_pe, g_conv, g_attn = jnp.split(proj, offs, axis=-1)
    y_conv = (gb * causal_depthwise_conv(gc * hc, conv_w)) @ w_conv_branch
    q = (rms_norm(q_lat, q_norm_g) @ w_uq).reshape(b, s, N_HEADS, QK_HEAD_DIM)
    q_nope, q_pe = q[..., :QK_NOPE_DIM], q[..., QK_NOPE_DIM:]
    q_pe = apply_rope(q_pe, cos[:, :, None, :], sin[:, :, None, :])
    ckv = rms_norm(kv_lat, kv_norm_g)
    k_nope = (ckv @ w_uk).reshape(b, s, N_HEADS, QK_NOPE_DIM)
    v = (ckv @ w_uv).reshape(b, s, N_HEADS, V_HEAD_DIM)
    k_pe = jnp.broadcast_to(apply_rope(k_pe, cos, sin)[:, :, None, :], (b, s, N_HEADS, QK_ROPE_DIM))
    q_full = jnp.concatenate([q_nope, q_pe], axis=-1)
    k_full = jnp.concatenate([k_nope, k_pe], axis=-1)
    attn = chunk_causal_attention(q_full, k_full, v).reshape(b, s, N_HEADS * V_HEAD_DIM)
    y_attn = attn @ w_attn_branch
    merged = jax.nn.sigmoid(g_conv) * y_conv + jax.nn.sigmoid(g_attn) * y_attn
    return merged @ w_out


def moe_ffn(x2d, w_router, b_router, w_gate_up, b_gate_up, w_down, b_down):
    t, d = x2d.shape
    n_assign = t * TOP_K
    logits = (x2d @ w_router + b_router).astype(jnp.float32)
    top_logits, top_idx = lax.top_k(logits, TOP_K)
    top_w = jax.nn.softmax(top_logits, axis=-1)
    flat_e = top_idx.reshape(-1)
    flat_tok = jnp.arange(n_assign, dtype=jnp.int32) // TOP_K
    flat_w = top_w.reshape(-1)
    order = jnp.argsort(flat_e)
    sorted_e = flat_e[order]
    counts = jnp.bincount(flat_e, length=N_EXPERTS)
    start = jnp.cumsum(counts) - counts
    padded = (counts + MOE_BLOCK - 1) // MOE_BLOCK * MOE_BLOCK
    padded_end = jnp.cumsum(padded)
    padded_start = padded_end - padded
    dest = padded_start[sorted_e] + (jnp.arange(n_assign, dtype=jnp.int32) - start[sorted_e])
    n_blocks = n_assign // MOE_BLOCK + N_EXPERTS
    n_slots = n_blocks * MOE_BLOCK
    slot_tok = jnp.zeros((n_slots,), jnp.int32).at[dest].set(flat_tok[order])
    slot_w = jnp.zeros((n_slots,), jnp.float32).at[dest].set(flat_w[order])
    block_e = jnp.minimum(jnp.searchsorted(padded_end, jnp.arange(n_blocks) * MOE_BLOCK, side='right'),
                          N_EXPERTS - 1)

    def expert_block(args):
        tok, e = args
        xb = x2d[tok]
        gu = xb @ w_gate_up[e] + b_gate_up[e]
        gate = jnp.minimum(gu[:, :D_FF_EXPERT], SWIGLU_LIMIT)
        up = jnp.clip(gu[:, D_FF_EXPERT:], -SWIGLU_LIMIT, SWIGLU_LIMIT)
        hid = (up + 1) * (gate * jax.nn.sigmoid(SWIGLU_ALPHA * gate))
        return hid @ w_down[e] + b_down[e]

    out = lax.map(expert_block, (slot_tok.reshape(n_blocks, MOE_BLOCK), block_e))
    out = out.reshape(n_slots, d) * slot_w[:, None].astype(out.dtype)
    return jnp.zeros_like(x2d).at[slot_tok].add(out)


def setup_inputs(seed: int = 0) -> dict:
    key = jax.random.key(seed)
    ks = jax.random.split(key, 24)
    L = DEPTH
    beta = DEEPNORM_BETA

    def nrm(k, shape, scale):
        return jax.random.normal(k, shape, jnp.float32) * scale

    def gain(k, dim):
        return jnp.ones((L, dim), jnp.float32) + 0.01 * jax.random.normal(k, (L, dim), jnp.float32)

    x = jax.random.normal(ks[0], (BATCH, SEQ, D_MODEL), jnp.float32)
    offset = jax.random.randint(ks[1], (BATCH, 1), 0, 8192, dtype=jnp.int32)
    positions = offset + jnp.arange(SEQ, dtype=jnp.int32)[None, :]
    return {
        "x": x,
        "positions": positions,
        "w_in": nrm(ks[2], (L, D_MODEL, IN_DIM), D_MODEL ** -0.5),
        "conv_w": nrm(ks[3], (L, CONV_WIDTH, CONV_DIM), CONV_WIDTH ** -0.5),
        "q_norm_g": gain(ks[4], Q_LORA_RANK),
        "w_uq": nrm(ks[5], (L, Q_LORA_RANK, N_HEADS * QK_HEAD_DIM), Q_LORA_RANK ** -0.5),
        "kv_norm_g": gain(ks[6], KV_LORA_RANK),
        "w_uk": nrm(ks[7], (L, KV_LORA_RANK, N_HEADS * QK_NOPE_DIM), KV_LORA_RANK ** -0.5),
        "w_uv": nrm(ks[8], (L, KV_LORA_RANK, N_HEADS * V_HEAD_DIM), beta * KV_LORA_RANK ** -0.5),
        "w_conv_branch": nrm(ks[9], (L, CONV_DIM, D_MODEL), beta * CONV_DIM ** -0.5),
        "w_attn_branch": nrm(ks[10], (L, N_HEADS * V_HEAD_DIM, D_MODEL), beta * (N_HEADS * V_HEAD_DIM) ** -0.5),
        "w_out": nrm(ks[11], (L, D_MODEL, D_MODEL), beta * D_MODEL ** -0.5),
        "ln1_g": gain(ks[12], D_MODEL),
        "ln1_b": nrm(ks[13], (L, D_MODEL), 0.01),
        "w_router": nrm(ks[14], (L, D_MODEL, N_EXPERTS), D_MODEL ** -0.5),
        "b_router": nrm(ks[15], (L, N_EXPERTS), 0.01),
        "w_gate_up": nrm(ks[16], (L, N_EXPERTS, D_MODEL, 2 * D_FF_EXPERT), beta * D_MODEL ** -0.5),
        "b_gate_up": nrm(ks[17], (L, N_EXPERTS, 2 * D_FF_EXPERT), 0.01),
        "w_down": nrm(ks[18], (L, N_EXPERTS, D_FF_EXPERT, D_MODEL), beta * D_FF_EXPERT ** -0.5),
        "b_down": nrm(ks[19], (L, N_EXPERTS, D_MODEL), 0.01),
        "ln2_g": gain(ks[20], D_MODEL),
        "ln2_b": nrm(ks[21], (L, D_MODEL), 0.01),
    }


def reference(x, positions, w_in, conv_w, q_norm_g, w_uq, kv_norm_g, w_uk, w_uv,
              w_conv_branch, w_attn_branch, w_out, ln1_g, ln1_b, w_router, b_router,
              w_gate_up, b_gate_up, w_down, b_down, ln2_g, ln2_b):
    b, s, d = x.shape
    cos, sin = rope_tables(positions, x.dtype)
    for l in range(DEPTH):
        mix = hybrid_mixer(x, cos, sin, w_in[l], conv_w[l], q_norm_g[l], w_uq[l], kv_norm_g[l],
                           w_uk[l], w_uv[l], w_conv_branch[l], w_attn_branch[l], w_out[l])
        x = layer_norm(DEEPNORM_ALPHA * x + mix, ln1_g[l], ln1_b[l])
        ffn = moe_ffn(x.reshape(b * s, d), w_router[l], b_router[l], w_gate_up[l], b_gate_up[l],
                      w_down[l], b_down[l]).reshape(b, s, d)
        x = layer_norm(DEEPNORM_ALPHA * x + ffn, ln2_g[l], ln2_b[l])
    return x
```

```cpp
#include <hip/hip_runtime.h>
#include <cstdio>
#include <cstdint>

#define GAS __attribute__((address_space(1)))
#define LAS __attribute__((address_space(3)))
typedef unsigned short bf16_t;
typedef short bf16x8 __attribute__((ext_vector_type(8)));
typedef short s16x4 __attribute__((ext_vector_type(4)));
typedef float f32x4 __attribute__((ext_vector_type(4)));
typedef float f32x2 __attribute__((ext_vector_type(2)));
typedef float f32x16 __attribute__((ext_vector_type(16)));
typedef unsigned u32x4 __attribute__((ext_vector_type(4)));
typedef unsigned u32x2 __attribute__((ext_vector_type(2)));

#ifndef MK_N_LAUNCHES
#define MK_N_LAUNCHES 1
#endif
constexpr int N_PHASES = 10;
constexpr int N_LAUNCHES = MK_N_LAUNCHES;
static_assert(N_LAUNCHES == 1 || N_LAUNCHES == N_PHASES, "MK_N_LAUNCHES is 1 or 10");

constexpr int BATCH = 4, SEQ = 4096, DM = 1024, T = BATCH * SEQ;
constexpr int NH = 8, DN = 128, DR = 64, DQK = 192, DV = 128, QL = 384, KVL = 256;
constexpr int NE = 32, DFF = 1024;
constexpr int IN_DIM = 5824, NPROJ = 5888;
constexpr int OFF_GB = 0, OFF_GC = 1024, OFF_HC = 2048, OFF_QL = 3072, OFF_KVL = 3456, OFF_KPE = 3712, OFF_GCONV = 3776, OFF_GATTN = 4800;
constexpr float LN_EPS = 1e-5f, RMS_EPS = 1e-6f, DN_ALPHA = 1.1892071150027210667f, SWI_LIMIT = 7.0f, SWI_ALPHA = 1.702f;
constexpr float LOG2E = 1.4426950408889634f;
constexpr float QSCALE = 0.07216878364870323f * LOG2E;
constexpr int LIST_CAP = T;
constexpr int MAX_MT = T * 4 / 256 + NE;

constexpr size_t MiB = 1u << 20;
constexpr size_t WS_CTL = 0, CTL_ZERO_BYTES = 1 * MiB;
constexpr size_t WS_SSQ = 256 * 1024;
constexpr size_t WS_XB = 1 * MiB;
constexpr size_t WS_WIN = 33 * MiB;
constexpr size_t WS_WUQ = 45 * MiB;
constexpr size_t WS_WKV = 47 * MiB;
constexpr size_t WS_WCB = 48 * MiB, WS_WAB = 50 * MiB, WS_WOUT = 52 * MiB;
constexpr size_t WS_TAB = 54 * MiB;
constexpr size_t WS_KPE = 58 * MiB;
constexpr size_t WS_TOP = 60 * MiB;
constexpr size_t WS_LIST = 61 * MiB;
constexpr size_t WS_WGU = 64 * MiB;
constexpr size_t WS_WD = 192 * MiB;
constexpr size_t WS_PROJ = 256 * MiB;
constexpr size_t WS_HID = WS_PROJ;
constexpr size_t WS_Q = 440 * MiB;
constexpr size_t WS_KN = 488 * MiB, WS_V = 520 * MiB, WS_CI = 552 * MiB;
constexpr size_t WS_EO = WS_Q;
constexpr size_t WS_YC = 584 * MiB, WS_AO = 616 * MiB, WS_MG = 648 * MiB;
constexpr size_t WS_H1 = 680 * MiB;
constexpr size_t WS_X1F = 744 * MiB;
constexpr size_t WS_X1B = 808 * MiB;
constexpr size_t WS_END = 840 * MiB;
static_assert(WS_HID + (size_t)MAX_MT * 256 * DFF * 2 <= WS_Q && WS_EO + (size_t)MAX_MT * 256 * DM * 2 <= WS_YC, "overlay map");
constexpr int CW_TMO = 0;
constexpr int CW_BAR = 4096;
constexpr int CW_CNT = 8192;

constexpr int RING_BYTES = 131072;
constexpr int MISC_OFF = 139264;
constexpr int LDS_BYTES = 147456;

#define LDS_WAIT() asm volatile("s_waitcnt lgkmcnt(0)" ::: "memory")
#define VM_WAIT() asm volatile("s_waitcnt vmcnt(0)" ::: "memory")
#define RLX_AGENT __ATOMIC_RELAXED, __HIP_MEMORY_SCOPE_AGENT

__device__ __forceinline__ unsigned pk_bf16(float lo, float hi) {
    typedef __bf16 b2 __attribute__((ext_vector_type(2)));
    f32x2 v = {lo, hi}; b2 b = __builtin_convertvector(v, b2); return __builtin_bit_cast(unsigned, b);
}
__device__ __forceinline__ float bf_lo(unsigned w) { return __uint_as_float(w << 16); }
__device__ __forceinline__ float bf_hi(unsigned w) { return __uint_as_float(w & 0xffff0000u); }
__device__ __forceinline__ float sigmoidf_(float x) { return __builtin_amdgcn_rcpf(1.0f + __builtin_amdgcn_exp2f(-x * LOG2E)); }
__device__ __forceinline__ float wave_sum(float v) {
#pragma unroll
    for (int o = 1; o < 64; o <<= 1) v += __shfl_xor(v, o);
    return v;
}

namespace pg8 {
constexpr int BM = 256, BK = 64, HALF = 128, HTB = HALF * BK * 2, STAGE_BYTES = 8 * HTB, NXCD = 8, WGM = 8;
__device__ __forceinline__ int lds_byte(int r, int c) { const int st = (r >> 4) * 2 + (c >> 5), rr = r & 15, cc = c & 31, ob = rr * 64 + cc * 2; return st * 1024 + (ob ^ (((ob >> 9) & 1) << 5)); }
__device__ __forceinline__ void stage_rc(int b, int& R, int& C) { const int st = b / 1024, sb = b % 1024, swz = sb ^ (((sb >> 9) & 1) << 5); R = (st >> 1) * 16 + swz / 64; C = (st & 1) * 32 + (swz % 64) / 2; }
__device__ __forceinline__ int perm32(int rho) { const int n = rho >> 4, i = rho & 15; return 8 * (i >> 2) + 4 * n + (i & 3); }

struct Unit { int pm, pn, pb, e; };
struct Gemm { const bf16_t* A; const bf16_t* Bt; int lda; int K; };

__device__ __forceinline__ void tile_of(int L, int nM, int nN, int& pm, int& pn) {
    const int nwg = nM * nN; int wgid = L;
    { const int q = nwg / NXCD, r = nwg % NXCD, xcd = wgid % NXCD, off = wgid / NXCD; wgid = (xcd < r ? xcd * (q + 1) : r * (q + 1) + (xcd - r) * q) + off; }
    const int nig = WGM * nN, gid = wgid / nig, fm = gid * WGM, gsz = (nM - fm) < WGM ? (nM - fm) : WGM;
    pm = fm + ((wgid % nig) % gsz); pn = (wgid % nig) / gsz;
}
struct StaticOrder {
    int nM, nN, nwg, G, c;
    __device__ void init(int M, int N, int G_, int c_) { nM = M / BM; nN = N / BM; nwg = nM * nN; G = G_; c = c_; }
    __device__ __forceinline__ bool next(int i, Unit& u) const {
        const long L = (long)i * G + c; if (L >= nwg) return false;
        tile_of((int)L, nM, nN, u.pm, u.pn); u.pb = u.pn; u.e = 0; return true;
    }
    __device__ __forceinline__ int arow(const Unit& u, int r) const { return u.pm * BM + r; }
};
template <bool GATHER> struct MoeOrder {
    int nM, nN, nwg, G, c; const volatile LAS int* tstart; const volatile LAS int* cnt; const int* list;
    __device__ __forceinline__ bool next(int i, Unit& u) const {
        const long L = (long)i * G + c; if (L >= nwg) return false;
        tile_of((int)L, nM, nN, u.pm, u.pn);
        int e = 0;
        for (int j = 1; j < NE; ++j) e += (tstart[j] <= u.pm) ? 1 : 0;
        u.e = e; u.pb = e * nN + u.pn; return true;
    }
    __device__ __forceinline__ int arow(const Unit& u, int r) const {
        if (!GATHER) return u.pm * BM + r;
        const int pos = (u.pm - tstart[u.e]) * BM + r;
        return pos < cnt[u.e] ? list[(size_t)u.e * LIST_CAP + pos] : 0;
    }
};

template <class Epi, class Sched, bool ALIGN_EPI>
__device__ __forceinline__ void gemm_phase(LAS unsigned char* lds, const Gemm g, const Sched& S, const Epi& E) {
    const int tid = threadIdx.x, wid = __builtin_amdgcn_readfirstlane(tid >> 6), lane = tid & 63, wr = wid >> 2, wc = wid & 3, fr = lane & 15, fq = lane >> 4;
    const int K = g.K, nt = K / BK, lda = g.lda;
    int Rr[2], Cc[2]; unsigned voffB[2];
#pragma unroll
    for (int i = 0; i < 2; ++i) { stage_rc(tid * 16 + i * 8192, Rr[i], Cc[i]); const int Rb = Epi::PERM ? ((Rr[i] & ~31) + perm32(Rr[i] & 31)) : Rr[i]; voffB[i] = (unsigned)(Rb * K + Cc[i]) * 2u; }
    const size_t kstep = (size_t)(BK * 2);
    const size_t hstepB = (size_t)HALF * K * 2, tstepB = 2 * hstepB;
    const unsigned ldsw = (unsigned)wid * 1024u;
    const int aoff = lds_byte(wr * 64 + fr, fq * 8), boff = lds_byte(wc * 32 + fr, fq * 8);
#define PG8_SA(b, h) (((b) * 2 + (h)) * HTB)
#define PG8_SB(b, h) ((4 + (b) * 2 + (h)) * HTB)
#define PG8_STAGE(bufoff, gbase, voff) do { _Pragma("unroll") for (int _i = 0; _i < 2; ++_i) \
        __builtin_amdgcn_global_load_lds((const unsigned*)((const char*)(gbase) + (voff)[_i]), (LAS unsigned*)(lds + (bufoff) + ldsw + _i * 8192), 16, 0, 0); } while (0)
#define PG8_LDA(dst, b, h) do { _Pragma("unroll") for (int m = 0; m < 4; ++m) _Pragma("unroll") for (int k = 0; k < 2; ++k) dst[m][k] = *(const LAS bf16x8*)(lds + PG8_SA(b, h) + aoff + m * 2048 + k * 1024); } while (0)
#define PG8_LDB(dst, b, h) do { _Pragma("unroll") for (int n = 0; n < 2; ++n) _Pragma("unroll") for (int k = 0; k < 2; ++k) dst[n][k] = *(const LAS bf16x8*)(lds + PG8_SB(b, h) + boff + n * 2048 + k * 1024); } while (0)
#define PG8_MMA(ai, bj, At, Bt) do { __builtin_amdgcn_s_setprio(1); _Pragma("unroll") for (int m = 0; m < 4; ++m) _Pragma("unroll") for (int n = 0; n < 2; ++n) _Pragma("unroll") for (int k = 0; k < 2; ++k) \
        acc[ai][bj][m][n] = __builtin_amdgcn_mfma_f32_16x16x32_bf16(Bt[n][k], At[m][k], acc[ai][bj][m][n], 0, 0, 0); __builtin_amdgcn_s_setprio(0); } while (0)
#define PG8_WAIT_V(n) asm volatile("s_waitcnt vmcnt(" #n ")" ::: "memory")
#define PG8_WAIT_L(n) asm volatile("s_waitcnt lgkmcnt(" #n ")" ::: "memory")
#define PG8_BAR __builtin_amdgcn_s_barrier()
#define PG8_SCHED __builtin_amdgcn_sched_barrier(0)
#define PG8_AOFF(dst, u) do { _Pragma("unroll") for (int _h = 0; _h < 2; ++_h) _Pragma("unroll") for (int _i = 0; _i < 2; ++_i) \
        dst[_h][_i] = ((unsigned)S.arow(u, _h * HALF + Rr[_i]) * (unsigned)lda + (unsigned)Cc[_i]) * 2u; } while (0)
    Unit cur, nxt; int ui = 0;
    if (!S.next(0, cur)) return;
    f32x4 acc[2][2][4][2];
#pragma unroll
    for (int a = 0; a < 2; ++a)
#pragma unroll
        for (int b = 0; b < 2; ++b)
#pragma unroll
            for (int m = 0; m < 4; ++m)
#pragma unroll
                for (int n = 0; n < 2; ++n) acc[a][b][m][n] = (f32x4){0.f, 0.f, 0.f, 0.f};
    bf16x8 At[4][2], B0[2][2], B1[2][2];
    unsigned vA[2][2], vN[2][2];
    PG8_AOFF(vA, cur);
    const char* const gA = (const char*)g.A;
    const char* cB = (const char*)g.Bt + (size_t)cur.pb * tstepB;
    PG8_STAGE(PG8_SB(0, 0), cB, voffB); PG8_STAGE(PG8_SB(0, 1), cB + hstepB, voffB); PG8_STAGE(PG8_SA(0, 0), gA, vA[0]); PG8_STAGE(PG8_SA(0, 1), gA, vA[1]);
    if (wr == 1) PG8_BAR;
    PG8_WAIT_V(2); PG8_BAR;
    PG8_STAGE(PG8_SB(1, 0), cB + kstep, voffB); PG8_STAGE(PG8_SA(1, 0), gA + kstep, vA[0]); PG8_STAGE(PG8_SB(1, 1), cB + hstepB + kstep, voffB);
    PG8_WAIT_V(6); PG8_BAR;
    for (;;) {
        const bool has_next = S.next(ui + 1, nxt);
        const char* nB = has_next ? (const char*)g.Bt + (size_t)nxt.pb * tstepB : cB;
        if (has_next) { PG8_AOFF(vN, nxt); } else {
#pragma unroll
            for (int h = 0; h < 2; ++h)
#pragma unroll
                for (int i = 0; i < 2; ++i) vN[h][i] = vA[h][i]; }
        _Pragma("nounroll") for (int t = 0; t < nt; t += 2) {
            const bool last = (t == nt - 2);
            const char* a1 = gA + (size_t)(t + 1) * kstep;
            const char* a2 = last ? gA : gA + (size_t)(t + 2) * kstep; const char* b2 = last ? nB : cB + (size_t)(t + 2) * kstep;
            const char* a3 = a2 + kstep; const char* b3 = b2 + kstep;
            unsigned v2[2][2];
#pragma unroll
            for (int h = 0; h < 2; ++h)
#pragma unroll
                for (int i = 0; i < 2; ++i) v2[h][i] = last ? vN[h][i] : vA[h][i];
            PG8_LDB(B0, 0, 0); PG8_LDB(B1, 0, 1); PG8_SCHED; PG8_LDA(At, 0, 0); PG8_STAGE(PG8_SA(1, 1), a1, vA[1]);
            PG8_WAIT_V(8); PG8_WAIT_L(0); PG8_BAR; PG8_MMA(0, 0, At, B0); PG8_MMA(0, 1, At, B1); PG8_BAR; PG8_SCHED;
            PG8_LDA(At, 0, 1); PG8_STAGE(PG8_SB(0, 0), b2, voffB); PG8_STAGE(PG8_SB(0, 1), b2 + hstepB, voffB); PG8_STAGE(PG8_SA(0, 0), a2, v2[0]);
            PG8_WAIT_V(8); PG8_WAIT_L(0); PG8_BAR; PG8_MMA(1, 0, At, B0); PG8_MMA(1, 1, At, B1); PG8_BAR; PG8_SCHED;
            PG8_LDB(B0, 1, 0); PG8_LDB(B1, 1, 1); PG8_SCHED; PG8_LDA(At, 1, 0); PG8_STAGE(PG8_SA(0, 1), a2, v2[1]);
            PG8_WAIT_V(8); PG8_WAIT_L(0); PG8_BAR; PG8_MMA(0, 0, At, B0); PG8_MMA(0, 1, At, B1); PG8_BAR; PG8_SCHED;
            PG8_LDA(At, 1, 1); PG8_STAGE(PG8_SB(1, 0), b3, voffB); PG8_STAGE(PG8_SB(1, 1), b3 + hstepB, voffB); PG8_STAGE(PG8_SA(1, 0), a3, v2[0]);
            PG8_WAIT_V(8); PG8_WAIT_L(0); PG8_BAR; PG8_MMA(1, 0, At, B0); PG8_MMA(1, 1, At, B1); PG8_BAR; PG8_SCHED;
        }
        if constexpr (ALIGN_EPI) { if (wr == 0) PG8_BAR; }
        E(acc, cur, wr, wc, fr, fq);
        if (!has_next) break;
#pragma unroll
        for (int a = 0; a < 2; ++a)
#pragma unroll
            for (int b = 0; b < 2; ++b)
#pragma unroll
                for (int m = 0; m < 4; ++m)
#pragma unroll
                    for (int n = 0; n < 2; ++n) acc[a][b][m][n] = (f32x4){0.f, 0.f, 0.f, 0.f};
        cur = nxt; cB = nB; ++ui;
#pragma unroll
        for (int h = 0; h < 2; ++h)
#pragma unroll
            for (int i = 0; i < 2; ++i) vA[h][i] = vN[h][i];
        if constexpr (ALIGN_EPI) { if (wr == 1) PG8_BAR; }
    }
    PG8_WAIT_V(0);
    if constexpr (!ALIGN_EPI) { if (wr == 0) PG8_BAR; }
    PG8_BAR;
#undef PG8_SA
#undef PG8_SB
#undef PG8_STAGE
#undef PG8_LDA
#undef PG8_LDB
#undef PG8_MMA
#undef PG8_WAIT_V
#undef PG8_WAIT_L
#undef PG8_BAR
#undef PG8_SCHED
#undef PG8_AOFF
}

typedef const f32x4 (&AccRef)[2][2][4][2];
__device__ __forceinline__ u32x4 pack8(f32x4 a, f32x4 b) { u32x4 w; w.x = pk_bf16(a[0], a[1]); w.y = pk_bf16(a[2], a[3]); w.z = pk_bf16(b[0], b[1]); w.w = pk_bf16(b[2], b[3]); return w; }
__device__ __forceinline__ void unpack8(u32x4 w, f32x4& a, f32x4& b) { a = (f32x4){bf_lo(w.x), bf_hi(w.x), bf_lo(w.y), bf_hi(w.y)}; b = (f32x4){bf_lo(w.z), bf_hi(w.z), bf_lo(w.w), bf_hi(w.w)}; }

struct EpiProj {
    static constexpr bool PERM = true;
    bf16_t* P; float* ssq_q; float* ssq_kv;
    __device__ __forceinline__ void operator()(AccRef acc, const Unit& u, int wr, int wc, int fr, int fq) const {
        const int row0 = u.pm * BM + wr * 64 + fr, col0 = u.pn * BM + wc * 32 + 8 * fq;
#pragma unroll
        for (int ai = 0; ai < 2; ++ai)
#pragma unroll
            for (int m = 0; m < 4; ++m) { bf16_t* rowp = P + (size_t)(row0 + ai * HALF + m * 16) * NPROJ + col0;
#pragma unroll
                for (int bj = 0; bj < 2; ++bj) *(u32x4*)(rowp + bj * HALF) = pack8(acc[ai][bj][m][0], acc[ai][bj][m][1]); }
#pragma unroll
        for (int bj = 0; bj < 2; ++bj) { const int hh = 2 * u.pn + bj;
            if (hh >= OFF_QL / 128 && hh < OFF_KPE / 128) { float* dst = (hh < OFF_KVL / 128) ? ssq_q : ssq_kv;
#pragma unroll
                for (int ai = 0; ai < 2; ++ai)
#pragma unroll
                    for (int m = 0; m < 4; ++m) { const f32x4 a = acc[ai][bj][m][0], b = acc[ai][bj][m][1];
                        float s = (a[0] * a[0] + a[1] * a[1]) + (a[2] * a[2] + a[3] * a[3]) + (b[0] * b[0] + b[1] * b[1]) + (b[2] * b[2] + b[3] * b[3]);
                        s += __shfl_xor(s, 16); s += __shfl_xor(s, 32);
                        if (fq == 0) atomicAdd(dst + row0 + ai * HALF + m * 16, s); } } }
    }
};
struct EpiQ {
    static constexpr bool PERM = true;
    bf16_t* Q; const float* ssq; const float* cs; const float* sn;
    __device__ __forceinline__ void operator()(AccRef acc, const Unit& u, int wr, int wc, int fr, int fq) const {
        const int row0 = u.pm * BM + wr * 64 + fr;
        if (u.pn < 4) {
#pragma unroll
            for (int ai = 0; ai < 2; ++ai)
#pragma unroll
                for (int m = 0; m < 4; ++m) { const int row = row0 + ai * HALF + m * 16;
                    const float rs = __builtin_amdgcn_rsqf(ssq[row] * (1.0f / QL) + RMS_EPS) * QSCALE;
#pragma unroll
                    for (int bj = 0; bj < 2; ++bj) { bf16_t* dst = Q + (size_t)row * (NH * DQK) + (2 * u.pn + bj) * DQK + wc * 32 + 8 * fq;
                        *(u32x4*)dst = pack8(acc[ai][bj][m][0] * rs, acc[ai][bj][m][1] * rs); } }
        } else {
            const int head = 4 * (u.pn - 4) + wc, i0 = 8 * fq;
#pragma unroll
            for (int ai = 0; ai < 2; ++ai)
#pragma unroll
                for (int m = 0; m < 4; ++m) { const int row = row0 + ai * HALF + m * 16;
                    const float rs = __builtin_amdgcn_rsqf(ssq[row] * (1.0f / QL) + RMS_EPS) * QSCALE;
                    const f32x4 c0 = *(const f32x4*)(cs + (size_t)row * 32 + i0), c1 = *(const f32x4*)(cs + (size_t)row * 32 + i0 + 4);
                    const f32x4 s0 = *(const f32x4*)(sn + (size_t)row * 32 + i0), s1 = *(const f32x4*)(sn + (size_t)row * 32 + i0 + 4);
                    const f32x4 x10 = acc[ai][0][m][0] * rs, x11 = acc[ai][0][m][1] * rs, x20 = acc[ai][1][m][0] * rs, x21 = acc[ai][1][m][1] * rs;
                    bf16_t* dst = Q + (size_t)row * (NH * DQK) + head * DQK + DN + i0;
                    *(u32x4*)dst = pack8(x10 * c0 - x20 * s0, x11 * c1 - x21 * s1);
                    *(u32x4*)(dst + 32) = pack8(x10 * s0 + x20 * c0, x11 * s1 + x21 * c1);
                    asm volatile("" ::: "memory"); }
        }
    }
};
struct EpiKV {
    static constexpr bool PERM = true;
    bf16_t* KN; bf16_t* V; const float* ssq;
    __device__ __forceinline__ void operator()(AccRef acc, const Unit& u, int wr, int wc, int fr, int fq) const {
        const int row0 = u.pm * BM + wr * 64 + fr; bf16_t* base = (u.pn < 4) ? KN : V; const int col0 = (u.pn & 3) * BM + wc * 32 + 8 * fq;
#pragma unroll
        for (int ai = 0; ai < 2; ++ai)
#pragma unroll
            for (int m = 0; m < 4; ++m) { const int row = row0 + ai * HALF + m * 16;
                const float rs = __builtin_amdgcn_rsqf(ssq[row] * (1.0f / KVL) + RMS_EPS);
#pragma unroll
                for (int bj = 0; bj < 2; ++bj) *(u32x4*)(base + (size_t)row * 1024 + col0 + bj * HALF) = pack8(acc[ai][bj][m][0] * rs, acc[ai][bj][m][1] * rs); }
    }
};
template <bool MERGE> struct EpiGate {
    static constexpr bool PERM = true;
    bf16_t* O; const bf16_t* P; int goff; const bf16_t* YC;
    __device__ __forceinline__ void operator()(AccRef acc, const Unit& u, int wr, int wc, int fr, int fq) const {
        const int row0 = u.pm * BM + wr * 64 + fr, col0 = u.pn * BM + wc * 32 + 8 * fq;
#pragma unroll
        for (int ai = 0; ai < 2; ++ai)
#pragma unroll
            for (int m = 0; m < 4; ++m) { const size_t row = (size_t)(row0 + ai * HALF + m * 16);
#pragma unroll
                for (int bj = 0; bj < 2; ++bj) { const int col = col0 + bj * HALF;
                    const u32x4 gw = *(const u32x4*)(P + row * NPROJ + goff + col); f32x4 g0, g1; unpack8(gw, g0, g1);
                    f32x4 v0 = acc[ai][bj][m][0], v1 = acc[ai][bj][m][1];
#pragma unroll
                    for (int j = 0; j < 4; ++j) { v0[j] *= sigmoidf_(g0[j]); v1[j] *= sigmoidf_(g1[j]); }
                    if (MERGE) { const u32x4 yw = *(const u32x4*)(YC + row * DM + col); f32x4 y0, y1; unpack8(yw, y0, y1); v0 += y0; v1 += y1; }
                    *(u32x4*)(O + row * DM + col) = pack8(v0, v1); } }
    }
};
struct EpiH1 {
    static constexpr bool PERM = false;
    float* H; const float* X;
    __device__ __forceinline__ void operator()(AccRef acc, const Unit& u, int wr, int wc, int fr, int fq) const {
        const int row0 = u.pm * BM + wr * 64 + fr, col0 = u.pn * BM + wc * 32 + 4 * fq;
#pragma unroll
        for (int ai = 0; ai < 2; ++ai)
#pragma unroll
            for (int m = 0; m < 4; ++m) { const size_t off = (size_t)(row0 + ai * HALF + m * 16) * DM + col0;
#pragma unroll
                for (int bj = 0; bj < 2; ++bj)
#pragma unroll
                    for (int n = 0; n < 2; ++n) { const f32x4 x = *(const f32x4*)(X + off + bj * HALF + n * 16); *(f32x4*)(H + off + bj * HALF + n * 16) = x * DN_ALPHA + acc[ai][bj][m][n]; } }
    }
};
struct EpiGU {
    static constexpr bool PERM = true;
    bf16_t* HID; const float* bias;
    __device__ __forceinline__ void operator()(AccRef acc, const Unit& u, int wr, int wc, int fr, int fq) const {
        const int row0 = u.pm * BM + wr * 64 + fr, c0 = u.pn * HALF + wc * 32 + 8 * fq;
        const float* bg = bias + (size_t)u.e * (2 * DFF) + c0;
        const f32x4 bg0 = *(const f32x4*)bg, bg1 = *(const f32x4*)(bg + 4), bu0 = *(const f32x4*)(bg + DFF), bu1 = *(const f32x4*)(bg + DFF + 4);
#pragma unroll
        for (int ai = 0; ai < 2; ++ai)
#pragma unroll
            for (int m = 0; m < 4; ++m) { f32x4 g0 = acc[ai][0][m][0] + bg0, g1 = acc[ai][0][m][1] + bg1, u0 = acc[ai][1][m][0] + bu0, u1 = acc[ai][1][m][1] + bu1;
#pragma unroll
                for (int j = 0; j < 4; ++j) {
                    float g = fminf(g0[j], SWI_LIMIT), up = fminf(fmaxf(u0[j], -SWI_LIMIT), SWI_LIMIT); g0[j] = (up + 1.0f) * (g * sigmoidf_(SWI_ALPHA * g));
                    g = fminf(g1[j], SWI_LIMIT); up = fminf(fmaxf(u1[j], -SWI_LIMIT), SWI_LIMIT); g1[j] = (up + 1.0f) * (g * sigmoidf_(SWI_ALPHA * g)); }
                *(u32x4*)(HID + (size_t)(row0 + ai * HALF + m * 16) * DFF + c0) = pack8(g0, g1); }
    }
};
struct EpiDown {
    static constexpr bool PERM = true;
    bf16_t* EO; const float* bias;
    __device__ __forceinline__ void operator()(AccRef acc, const Unit& u, int wr, int wc, int fr, int fq) const {
        const int row0 = u.pm * BM + wr * 64 + fr, col0 = u.pn * BM + wc * 32 + 8 * fq;
        f32x4 bv[2][2];
#pragma unroll
        for (int bj = 0; bj < 2; ++bj)
#pragma unroll
            for (int n = 0; n < 2; ++n) bv[bj][n] = *(const f32x4*)(bias + (size_t)u.e * DM + col0 + bj * HALF + 4 * n);
#pragma unroll
        for (int ai = 0; ai < 2; ++ai)
#pragma unroll
            for (int m = 0; m < 4; ++m) { bf16_t* rowp = EO + (size_t)(row0 + ai * HALF + m * 16) * DM + col0;
#pragma unroll
                for (int bj = 0; bj < 2; ++bj) *(u32x4*)(rowp + bj * HALF) = pack8(acc[ai][bj][m][0] + bv[bj][0], acc[ai][bj][m][1] + bv[bj][1]); }
    }
};
}

namespace att {
constexpr int NW = 8, QBLK = 32, KVBLK = 64;
constexpr int LDQ = NH * DQK, LDK = NH * DN, LDP = DR, LDO = NH * DV;
constexpr int SHM_V = KVBLK * DV * 2, SHM_KN = KVBLK * DN * 2, SHM_KP = KVBLK * DR * 2;
constexpr int OFF_V = 0, OFF_KN = 2 * SHM_V, OFF_KP = OFF_KN + 2 * SHM_KN, OFF_WS = OFF_KP + 2 * SHM_KP, ATT_LDS = OFF_WS + NW * 64 * 4;
static_assert(ATT_LDS <= RING_BYTES && MISC_OFF + 2048 <= LDS_BYTES && 8 * 16896 <= MISC_OFF, "LDS map");
constexpr float THR = 8.0f;
#define KSWZ(row, colB) ((row) * 256 + ((colB) ^ (((row) & 7) << 4)))
#define PSWZ(row, colB) ((row) * 128 + ((colB) ^ (((row) & 7) << 4)))
#define SBAR() __builtin_amdgcn_sched_barrier(0)
__device__ __forceinline__ int crow(int r, int hi) { return (r & 3) + 8 * (r >> 2) + 4 * hi; }

__device__ __forceinline__ void partialSM(f32x16& p0, f32x16& p1, float& m_reg, float& mn, float& alpha) {
    float pmax = p0[0];
#pragma unroll
    for (int r = 1; r < 16; ++r) pmax = fmaxf(pmax, p0[r]);
#pragma unroll
    for (int r = 0; r < 16; ++r) pmax = fmaxf(pmax, p1[r]);
    { auto rr = __builtin_amdgcn_permlane32_swap(__float_as_uint(pmax), __float_as_uint(pmax), false, false); pmax = fmaxf(__uint_as_float(rr[0]), __uint_as_float(rr[1])); }
    if (__builtin_expect(__all(pmax - m_reg <= THR), 1)) { mn = m_reg; alpha = 1.f; }
    else { mn = fmaxf(m_reg, pmax); alpha = __builtin_amdgcn_exp2f(m_reg - mn); m_reg = mn; }
#pragma unroll
    for (int r = 0; r < 16; ++r) { p0[r] -= mn; p1[r] -= mn; }
#pragma unroll
    for (int r = 0; r < 16; ++r) p0[r] = __builtin_amdgcn_exp2f(p0[r]);
}
__device__ __forceinline__ void finishSM(f32x16& p0, f32x16& p1, float alpha, float& l_reg, bf16x8& pa0, bf16x8& pa1, bf16x8& pa2, bf16x8& pa3) {
#pragma unroll
    for (int r = 0; r < 16; ++r) p1[r] = __builtin_amdgcn_exp2f(p1[r]);
    float ps = 0;
#pragma unroll
    for (int r = 0; r < 16; ++r) ps += p0[r];
#pragma unroll
    for (int r = 0; r < 16; ++r) ps += p1[r];
    { auto rr = __builtin_amdgcn_permlane32_swap(__float_as_uint(ps), __float_as_uint(ps), false, false); ps = __uint_as_float(rr[0]) + __uint_as_float(rr[1]); }
    l_reg = l_reg * alpha + ps;
#define PK4(P, BASE, OUT) do { unsigned a0 = pk_bf16(P[BASE + 0], P[BASE + 1]), a1 = pk_bf16(P[BASE + 2], P[BASE + 3]);   \
    unsigned b0 = pk_bf16(P[BASE + 4], P[BASE + 5]), b1 = pk_bf16(P[BASE + 6], P[BASE + 7]);                              \
    auto r0 = __builtin_amdgcn_permlane32_swap(a0, b0, false, false); auto r1 = __builtin_amdgcn_permlane32_swap(a1, b1, false, false); \
    u32x4 w = {r0[0], r1[0], r0[1], r1[1]}; OUT = __builtin_bit_cast(bf16x8, w); } while (0)
    PK4(p0, 0, pa0); PK4(p0, 8, pa1); PK4(p1, 0, pa2); PK4(p1, 8, pa3);
#undef PK4
}
__device__ __forceinline__ void qkt(f32x16& p0, f32x16& p1, const LAS unsigned char* Kn, const LAS unsigned char* Kp, const bf16x8* qr, const int* kx, const int* px, bool masked) {
    p0 = f32x16{}; p1 = f32x16{};
#pragma unroll
    for (int d0 = 0; d0 < 8; ++d0) {
        const bf16x8 b0 = *(const LAS bf16x8*)(Kn + kx[d0 & 3] + (d0 >> 2) * 128);
        const bf16x8 b1 = *(const LAS bf16x8*)(Kn + kx[d0 & 3] + (d0 >> 2) * 128 + 8192);
        p0 = __builtin_amdgcn_mfma_f32_32x32x16_bf16(b0, qr[d0], p0, 0, 0, 0);
        p1 = __builtin_amdgcn_mfma_f32_32x32x16_bf16(b1, qr[d0], p1, 0, 0, 0); }
#pragma unroll
    for (int d0 = 0; d0 < 4; ++d0) {
        const bf16x8 b0 = *(const LAS bf16x8*)(Kp + px[d0]);
        const bf16x8 b1 = *(const LAS bf16x8*)(Kp + px[d0] + 4096);
        p0 = __builtin_amdgcn_mfma_f32_32x32x16_bf16(b0, qr[8 + d0], p0, 0, 0, 0);
        p1 = __builtin_amdgcn_mfma_f32_32x32x16_bf16(b1, qr[8 + d0], p1, 0, 0, 0); }
    if (masked) {
#pragma unroll
        for (int r = 0; r < 16; ++r) { p0[r] = -INFINITY; p1[r] = -INFINITY; } }
}
__device__ __forceinline__ int v_st(int k, int c) { const int kk = (k & ~0xC) | ((k & 4) << 1) | ((k & 8) >> 1); return ((kk >> 3) * 4 + (c >> 5)) * 512 + ((kk & 7) * 32 + (c & 31)) * 2; }
__device__ __forceinline__ int v_rd_base(int lane) { return ((lane & 3) << 3) | (((lane >> 2) & 3) << 6) | (((lane >> 4) & 1) << 5) | (((lane >> 5) & 1) << 8); }
constexpr int v_rd_off(int d0, int ks, int half) { return d0 * 512 + ks * 4096 + half * 2048; }
template <int OFF> __device__ __forceinline__ s16x4 tr_read(int vb) { s16x4 r; asm volatile("ds_read_b64_tr_b16 %0, %1 offset:%2" : "=&v"(r) : "v"(vb), "i"(OFF) : "memory"); return r; }
template <int D0> __device__ __forceinline__ void pv_one(f32x16& od, int vb, bf16x8 pa0, bf16x8 pa1, bf16x8 pa2, bf16x8 pa3) {
    const s16x4 l0 = tr_read<v_rd_off(D0, 0, 0)>(vb), h0 = tr_read<v_rd_off(D0, 0, 1)>(vb), l1 = tr_read<v_rd_off(D0, 1, 0)>(vb), h1 = tr_read<v_rd_off(D0, 1, 1)>(vb);
    const s16x4 l2 = tr_read<v_rd_off(D0, 2, 0)>(vb), h2 = tr_read<v_rd_off(D0, 2, 1)>(vb), l3 = tr_read<v_rd_off(D0, 3, 0)>(vb), h3 = tr_read<v_rd_off(D0, 3, 1)>(vb);
    asm volatile("s_waitcnt lgkmcnt(0)" ::: "memory"); SBAR();
#define PK(L, H) (bf16x8){L[0], L[1], L[2], L[3], H[0], H[1], H[2], H[3]}
    od = __builtin_amdgcn_mfma_f32_32x32x16_bf16(pa0, PK(l0, h0), od, 0, 0, 0);
    od = __builtin_amdgcn_mfma_f32_32x32x16_bf16(pa1, PK(l1, h1), od, 0, 0, 0);
    od = __builtin_amdgcn_mfma_f32_32x32x16_bf16(pa2, PK(l2, h2), od, 0, 0, 0);
    od = __builtin_amdgcn_mfma_f32_32x32x16_bf16(pa3, PK(l3, h3), od, 0, 0, 0);
#undef PK
}
__device__ __forceinline__ void pv_d0(f32x16* o, int vb, bf16x8 pa0, bf16x8 pa1, bf16x8 pa2, bf16x8 pa3) {
    pv_one<0>(o[0], vb, pa0, pa1, pa2, pa3); pv_one<1>(o[1], vb, pa0, pa1, pa2, pa3); pv_one<2>(o[2], vb, pa0, pa1, pa2, pa3); pv_one<3>(o[3], vb, pa0, pa1, pa2, pa3);
}

__device__ __forceinline__ void attn_unit(int b, int h, int qb, const bf16_t* __restrict__ Q, const bf16_t* __restrict__ KN, const bf16_t* __restrict__ KP, const bf16_t* __restrict__ V, bf16_t* __restrict__ O, LAS unsigned char* lds) {
    const int tid = threadIdx.x, wid = __builtin_amdgcn_readfirstlane(tid >> 6), lane = tid & 63, r32 = lane & 31, hi = lane >> 5;
    LAS float* ws = (LAS float*)(lds + OFF_WS) + wid * 64; LAS float* li_l = ws; LAS float* al_l = ws + 32;
    const size_t rowbase = (size_t)b * SEQ; const int q0 = qb * (QBLK * NW);
    float m_reg = -1e30f, l_reg = 0; f32x16 o[4] = {}; bf16x8 qr[12];
    { const char* qbase = (const char*)(Q + (rowbase + q0 + wid * QBLK) * LDQ + h * DQK); const unsigned qoff = (unsigned)(r32 * LDQ + hi * 8) * 2u;
#pragma unroll
      for (int d0 = 0; d0 < 12; ++d0) qr[d0] = *reinterpret_cast<const bf16x8*>(qbase + qoff + d0 * 32); }
    const bf16_t* Kh = KN + rowbase * LDK + h * DN; const bf16_t* Vh = V + rowbase * LDK + h * DV; const bf16_t* Ph = KP + rowbase * LDP;
    unsigned gk0, gp0, gv0;
    { const int row = wid * 4 + (lane >> 4); gk0 = (unsigned)(row * (LDK * 2) + (((lane & 15) ^ (row & 7)) << 4)); }
    { const int row = wid * 8 + (lane >> 3); gp0 = (unsigned)(row * (LDP * 2) + (((lane & 7) ^ (row & 7)) << 4)); }
    { const int st = 2 * wid + (lane >> 5), q = lane & 31, kk = (st >> 2) * 8 + (q >> 2), c = (st & 3) * 32 + (q & 3) * 8, k = (kk & ~0xC) | ((kk & 4) << 1) | ((kk & 8) >> 1); gv0 = (unsigned)(k * (LDK * 2) + c * 2); }
    const unsigned ldsw = (unsigned)wid * 1024u;
#define GLDS(src, dst) __builtin_amdgcn_global_load_lds((const unsigned*)(src), (LAS unsigned*)(dst), 16, 0, 0)
#define DMA_K(j, bb) do { const char* kt_ = (const char*)(Kh + (size_t)(j) * KVBLK * LDK); const char* pt_ = (const char*)(Ph + (size_t)(j) * KVBLK * LDP); \
    GLDS(kt_ + gk0, lds + OFF_KN + (bb) * SHM_KN + ldsw); GLDS(kt_ + gk0 + 32 * LDK * 2, lds + OFF_KN + (bb) * SHM_KN + 8192 + ldsw); GLDS(pt_ + gp0, lds + OFF_KP + (bb) * SHM_KP + ldsw); } while (0)
#define DMA_V(j, bb) do { const char* vt_ = (const char*)(Vh + (size_t)(j) * KVBLK * LDK); \
    GLDS(vt_ + gv0, lds + OFF_V + (bb) * SHM_V + ldsw); GLDS(vt_ + gv0 + 32 * LDK * 2, lds + OFF_V + (bb) * SHM_V + 8192 + ldsw); } while (0)
#define STEP_END() do { asm volatile("s_waitcnt vmcnt(0) lgkmcnt(0)" ::: "memory"); __builtin_amdgcn_s_barrier(); asm volatile("" ::: "memory"); } while (0)
#define RESC(a) do { if (__any((a) < 1.f)) { if (hi == 0) al_l[r32] = (a); asm volatile("s_waitcnt lgkmcnt(0)" ::: "memory"); \
    _Pragma("unroll") for (int d = 0; d < 4; ++d) _Pragma("unroll") for (int r = 0; r < 16; ++r) o[d][r] *= al_l[crow(r, hi)]; } } while (0)
    int kx[4], px[4];
#pragma unroll
    for (int q = 0; q < 4; ++q) { kx[q] = r32 * 256 + (((2 * q + hi) ^ (r32 & 7)) << 4); px[q] = r32 * 128 + (((2 * q + hi) ^ (r32 & 7)) << 4); }
    const LAS unsigned char* K0 = lds + OFF_KN; const LAS unsigned char* K1 = lds + OFF_KN + SHM_KN; const LAS unsigned char* P0 = lds + OFF_KP; const LAS unsigned char* P1 = lds + OFF_KP + SHM_KP;
    const int vb0 = (int)(uintptr_t)(lds + OFF_V) + v_rd_base(lane);
    const int NT = 4 * qb + 4, jmax = 4 * qb + (wid >> 1);
    f32x16 pA0, pA1, pB0, pB1; float mnA, mnB, alA, alB; bf16x8 pa0, pa1, pa2, pa3;
    DMA_K(0, 0);
    STEP_END();
    DMA_K(1, 1); DMA_V(0, 0);
    qkt(pA0, pA1, K0, P0, qr, kx, px, false); partialSM(pA0, pA1, m_reg, mnA, alA);
    STEP_END();
    for (int j = 1; j + 1 < NT; j += 2) {
        DMA_K(j + 1, 0); DMA_V(j, 1);
        SBAR(); qkt(pB0, pB1, K1, P1, qr, kx, px, j > jmax);
        finishSM(pA0, pA1, alA, l_reg, pa0, pa1, pa2, pa3); SBAR();
        pv_d0(o, vb0, pa0, pa1, pa2, pa3); partialSM(pB0, pB1, m_reg, mnB, alB);
        RESC(alB);
        STEP_END();
        DMA_K(j + 2, 1); DMA_V(j + 1, 0);
        SBAR(); qkt(pA0, pA1, K0, P0, qr, kx, px, j + 1 > jmax);
        finishSM(pB0, pB1, alB, l_reg, pa0, pa1, pa2, pa3); SBAR();
        pv_d0(o, vb0 + SHM_V, pa0, pa1, pa2, pa3); partialSM(pA0, pA1, m_reg, mnA, alA);
        RESC(alA);
        STEP_END();
    }
    DMA_V(NT - 1, 1);
    SBAR(); qkt(pB0, pB1, K1, P1, qr, kx, px, NT - 1 > jmax);
    finishSM(pA0, pA1, alA, l_reg, pa0, pa1, pa2, pa3); SBAR();
    pv_d0(o, vb0, pa0, pa1, pa2, pa3); partialSM(pB0, pB1, m_reg, mnB, alB);
    RESC(alB);
    STEP_END();
    finishSM(pB0, pB1, alB, l_reg, pa0, pa1, pa2, pa3); SBAR();
    pv_d0(o, vb0 + SHM_V, pa0, pa1, pa2, pa3);
    if (hi == 0) li_l[r32] = l_reg;
    asm volatile("s_waitcnt lgkmcnt(0)" ::: "memory");
    float rli[16];
#pragma unroll
    for (int r = 0; r < 16; ++r) rli[r] = __builtin_amdgcn_rcpf(li_l[crow(r, hi)]);
    STEP_END();
    { LAS bf16_t* stg = (LAS bf16_t*)lds + wid * (QBLK * DV);
        int ln = lane; asm volatile("" : "+v"(ln));
        const int r32e = ln & 31, hie = ln >> 5;
#pragma unroll
        for (int r = 0; r < 16; ++r) { const int orow = crow(r, hie);
#pragma unroll
            for (int d0 = 0; d0 < 4; ++d0) stg[orow * DV + d0 * 32 + r32e] = (bf16_t)(pk_bf16(o[d0][r] * rli[r], 0.f) & 0xffffu); }
        asm volatile("s_waitcnt lgkmcnt(0)" ::: "memory");
        char* Ow = (char*)(O + (rowbase + q0 + wid * QBLK) * LDO + h * DV);
        const unsigned ooff = (unsigned)((ln >> 4) * LDO + (ln & 15) * 8) * 2u; const int soff = (ln >> 4) * DV + (ln & 15) * 8;
#pragma unroll
        for (int i = 0; i < 8; ++i) { const u32x4 v = *(const LAS u32x4*)(stg + soff + i * 4 * DV); *(u32x4*)(Ow + ooff + (unsigned)(i * 4 * LDO * 2)) = v; } }
    STEP_END();
#undef GLDS
#undef DMA_K
#undef DMA_V
#undef STEP_END
#undef RESC
}
#undef KSWZ
#undef PSWZ
#undef SBAR
}

#define XB_TMO      128
#define XB_XCNT(j)  (256  + 64 * (j))
#define XB_XSUB(j)  (1280 + 64 * (j))
#define XB_XGEN(j)  (2304 + 64 * (j))
#define XB_TOP      3328
#define XB_TOPGEN   3392
#define XCD_BAR_WORDS 3456
#define XB_SPIN_CAP (1u << 18)
__device__ __forceinline__ unsigned xb_ld(unsigned* p)              { return __hip_atomic_load(p, __ATOMIC_RELAXED, __HIP_MEMORY_SCOPE_AGENT); }
__device__ __forceinline__ unsigned xb_add(unsigned* p, unsigned v) { return __hip_atomic_fetch_add(p, v, __ATOMIC_RELAXED, __HIP_MEMORY_SCOPE_AGENT); }
__device__ __forceinline__ unsigned xb_xcc_id() { return (unsigned)__builtin_amdgcn_s_getreg((3 << 11) | 20) & 0xFu; }
#define XB_SPIN(cond, bar) do { unsigned _sp = 0; while (cond) { __builtin_amdgcn_s_sleep(1); \
    if ((++_sp & 255u) == 0u) { if (xb_ld(&(bar)[XB_TMO])) break; if (_sp > XB_SPIN_CAP) { atomicAdd(&(bar)[XB_TMO], 1u); break; } } } } while (0)
struct XcdBarrier { unsigned* bar; unsigned x; volatile LAS unsigned* st; };
__device__ __forceinline__ XcdBarrier xcd_barrier_post(unsigned* bar, volatile LAS unsigned* st) {
    XcdBarrier b; b.bar = bar; b.x = xb_xcc_id(); b.st = st;
    if (threadIdx.x == 0) (void)xb_add(&bar[XB_XCNT(b.x)], 1u);
    return b;
}
__device__ __forceinline__ void xcd_barrier_complete(unsigned* bar, unsigned x, unsigned& nloc, unsigned& nx) {
    const unsigned G = gridDim.x * gridDim.y * gridDim.z;
    unsigned sum, cnt, mine, sp = 0u;
    for (;;) {
        sum = 0u; cnt = 0u; mine = 0u;
#pragma unroll
        for (unsigned j = 0; j < 16; ++j) { const unsigned c = xb_ld(&bar[XB_XCNT(j)]); sum += c; cnt += (c > 0u) ? 1u : 0u; mine = (j == x) ? c : mine; }
        if (sum == G) break;
        __builtin_amdgcn_s_sleep(1);
        if ((++sp & 255u) == 0u) { if (xb_ld(&bar[XB_TMO])) break; if (sp > XB_SPIN_CAP) { atomicAdd(&bar[XB_TMO], 1u); break; } }
    }
    nloc = mine > 0u ? mine : 1u; nx = cnt > 0u ? cnt : 1u;
}
__device__ __forceinline__ void xcd_barrier(const XcdBarrier& b) {
    asm volatile("s_waitcnt vmcnt(0)" ::: "memory");
    __syncthreads();
    if (threadIdx.x == 0) {
        unsigned* bar = b.bar;
        __builtin_amdgcn_s_waitcnt(0);
        unsigned nloc = b.st[0], nx = b.st[1];
        if (nloc == 0u) { xcd_barrier_complete(bar, b.x, nloc, nx); b.st[0] = nloc; b.st[1] = nx; }
        const unsigned old = xb_add(&bar[XB_XSUB(b.x)], 1u);
        const unsigned gen = old / nloc;
        if (old + 1u == (gen + 1u) * nloc) {
            __builtin_amdgcn_fence(__ATOMIC_RELEASE, "agent");
            asm volatile("s_waitcnt vmcnt(0)" ::: "memory");
            const unsigned og = xb_add(&bar[XB_TOP], 1u);
            const unsigned tg = og / nx;
            if (og + 1u == (tg + 1u) * nx) xb_add(&bar[XB_TOPGEN], 1u);
            else XB_SPIN(xb_ld(&bar[XB_TOPGEN]) == tg, bar);
            __builtin_amdgcn_fence(__ATOMIC_ACQUIRE, "agent");
            xb_add(&bar[XB_XGEN(b.x)], 1u);
            asm volatile("s_waitcnt vmcnt(0)" ::: "memory");
        } else {
            XB_SPIN(xb_ld(&bar[XB_XGEN(b.x)]) == gen, bar);
            __builtin_amdgcn_fence(__ATOMIC_ACQUIRE, "agent");
            asm volatile("s_waitcnt vmcnt(0)" ::: "memory");
        }
    }
    __syncthreads();
}

__device__ __forceinline__ void tr_item(const float* __restrict__ W, int N, int k0, int n0, bf16_t* __restrict__ WT, int Kd, size_t dlo, size_t dhi, const float* __restrict__ g, LAS float* scr, int lane) {
#pragma unroll 4
    for (int i = 0; i < 16; ++i) { const int k = 4 * i + (lane >> 4), n = 4 * (lane & 15);
        f32x4 v = *(const f32x4*)(W + (size_t)(k0 + k) * N + n0 + n);
        if (g) v = v * g[k0 + k];
        LAS float* s = scr + k * 65 + n; s[0] = v[0]; s[1] = v[1]; s[2] = v[2]; s[3] = v[3]; }
    LDS_WAIT(); asm volatile("" ::: "memory");
    const int c = lane & 7;
#pragma unroll
    for (int j = 0; j < 8; ++j) { const int n = (lane >> 3) + 8 * j; const LAS float* s = scr + (8 * c) * 65 + n;
        u32x4 o; o.x = pk_bf16(s[0 * 65], s[1 * 65]); o.y = pk_bf16(s[2 * 65], s[3 * 65]); o.z = pk_bf16(s[4 * 65], s[5 * 65]); o.w = pk_bf16(s[6 * 65], s[7 * 65]);
        const size_t drow = (n < 32) ? dlo + n : dhi + (n - 32);
        *(u32x4*)(WT + drow * Kd + k0 + 8 * c) = o; }
    LDS_WAIT(); asm volatile("" ::: "memory");
}

struct Args { const void* in[22]; float* out; unsigned char* ws; int ph_lo, ph_hi; };

__global__ void __launch_bounds__(512, 2) mk_fwd(Args args) {
    extern __shared__ __attribute__((aligned(16))) unsigned char lds_raw[];
    LAS unsigned char* lds = (LAS unsigned char*)lds_raw;
    volatile LAS unsigned* MISC = (volatile LAS unsigned*)(lds + MISC_OFF);
    volatile LAS int* TST = (volatile LAS int*)(lds + MISC_OFF + 64);
    volatile LAS int* CNT = (volatile LAS int*)(lds + MISC_OFF + 256);
    const int tid = threadIdx.x, lane = tid & 63, wave = __builtin_amdgcn_readfirstlane(tid >> 6);
    const int G = gridDim.x, bx = blockIdx.x;
    const int vcu = (G % 8 == 0) ? (bx % 8) * (G / 8) + bx / 8 : bx;
    unsigned char* ws = args.ws;
    unsigned* ctl = (unsigned*)(ws + WS_CTL);
    const float* x = (const float*)args.in[0]; const int* positions = (const int*)args.in[1];
    const float* w_in = (const float*)args.in[2]; const float* conv_w = (const float*)args.in[3]; const float* q_norm_g = (const float*)args.in[4];
    const float* w_uq = (const float*)args.in[5]; const float* kv_norm_g = (const float*)args.in[6]; const float* w_uk = (const float*)args.in[7]; const float* w_uv = (const float*)args.in[8];
    const float* w_cb = (const float*)args.in[9]; const float* w_ab = (const float*)args.in[10]; const float* w_out = (const float*)args.in[11];
    const float* ln1_g = (const float*)args.in[12]; const float* ln1_b = (const float*)args.in[13]; const float* w_router = (const float*)args.in[14]; const float* b_router = (const float*)args.in[15];
    const float* w_gu = (const float*)args.in[16]; const float* b_gu = (const float*)args.in[17]; const float* w_dn = (const float*)args.in[18]; const float* b_dn = (const float*)args.in[19];
    const float* ln2_g = (const float*)args.in[20]; const float* ln2_b = (const float*)args.in[21];
    float* out = args.out;
    float* ssq_q = (float*)(ws + WS_SSQ); float* ssq_kv = ssq_q + T;
    bf16_t* XB = (bf16_t*)(ws + WS_XB); bf16_t* WinT = (bf16_t*)(ws + WS_WIN); bf16_t* WuqT = (bf16_t*)(ws + WS_WUQ); bf16_t* WkvT = (bf16_t*)(ws + WS_WKV);
    bf16_t* WcbT = (bf16_t*)(ws + WS_WCB); bf16_t* WabT = (bf16_t*)(ws + WS_WAB); bf16_t* WoutT = (bf16_t*)(ws + WS_WOUT);
    float* tab_cos = (float*)(ws + WS_TAB); float* tab_sin = tab_cos + (size_t)T * 32;
    bf16_t* KPE = (bf16_t*)(ws + WS_KPE);
    int* tope = (int*)(ws + WS_TOP); float* topw = (float*)(tope + (size_t)T * 4); int* tpos = (int*)(topw + (size_t)T * 4);
    int* list = (int*)(ws + WS_LIST);
    bf16_t* WguT = (bf16_t*)(ws + WS_WGU); bf16_t* WdT = (bf16_t*)(ws + WS_WD);
    bf16_t* PROJ = (bf16_t*)(ws + WS_PROJ); bf16_t* HID = (bf16_t*)(ws + WS_HID);
    bf16_t* Qb = (bf16_t*)(ws + WS_Q); bf16_t* KNb = (bf16_t*)(ws + WS_KN); bf16_t* Vb = (bf16_t*)(ws + WS_V); bf16_t* CI = (bf16_t*)(ws + WS_CI); bf16_t* EO = (bf16_t*)(ws + WS_EO);
    bf16_t* YC = (bf16_t*)(ws + WS_YC); bf16_t* AO = (bf16_t*)(ws + WS_AO); bf16_t* MG = (bf16_t*)(ws + WS_MG);
    float* H1 = (float*)(ws + WS_H1); float* X1F = (float*)(ws + WS_X1F); bf16_t* X1B = (bf16_t*)(ws + WS_X1B);
    unsigned* ecnt = ctl + CW_CNT;

    for (int u = tid; u < 256; u += 512) ((LAS unsigned*)(lds + MISC_OFF))[u] = 0u;
    __syncthreads();
    XcdBarrier bar; bar.bar = ctl + CW_BAR; bar.x = 0; bar.st = nullptr;
    if (N_LAUNCHES == 1) bar = xcd_barrier_post(ctl + CW_BAR, MISC);
    const int lo = args.ph_lo, hi = args.ph_hi;
#ifndef MK_PHASE_MASK
#define MK_PHASE_MASK 0x3ff
#endif
#define IN(k) ((((MK_PHASE_MASK) >> (k)) & 1) && lo <= (k) && (k) < hi)
#define GRID_BAR(k) do { if (IN(k) && IN((k) + 1)) xcd_barrier(bar); } while (0)
    const int gw = vcu * 8 + wave, NGW = G * 8;
    const int gt = vcu * 512 + tid, NGT = G * 512;

    if (IN(0)) {
        LAS float* scr = (LAS float*)(lds + wave * 16896);
        constexpr int I_IN = 16 * 91, I_UQ = 6 * 24, I_UK = 4 * 16, I_UV = 4 * 16, I_SQ = 16 * 16, I_GU = NE * 16 * 32, I_DN = NE * 16 * 16;
        constexpr int NITEMS = I_IN + I_UQ + I_UK + I_UV + 3 * I_SQ + I_GU + I_DN;
        for (int it = gw; it < NITEMS; it += NGW) {
            int r = it;
            if (r < I_GU) { const int e = r / 512, rr = r % 512, kb = rr / 32, nb = rr % 32; const int n0 = 64 * nb;
                const size_t d = (n0 < DFF) ? (size_t)(256 * (n0 / 128) + (n0 % 128)) : (size_t)(256 * ((n0 - DFF) / 128) + 128 + (n0 - DFF) % 128);
                tr_item(w_gu + (size_t)e * DM * 2 * DFF, 2 * DFF, 64 * kb, n0, WguT + (size_t)e * 2 * DFF * DM, DM, d, d + 32, nullptr, scr, lane); continue; } r -= I_GU;
            if (r < I_DN) { const int e = r / 256, rr = r % 256, kb = rr / 16, nb = rr % 16;
                tr_item(w_dn + (size_t)e * DFF * DM, DM, 64 * kb, 64 * nb, WdT + (size_t)e * DM * DFF, DFF, 64 * nb, 64 * nb + 32, nullptr, scr, lane); continue; } r -= I_DN;
            if (r < I_IN) { const int kb = r / 91, nb = r % 91; tr_item(w_in, IN_DIM, 64 * kb, 64 * nb, WinT, DM, 64 * nb, 64 * nb + 32, nullptr, scr, lane); continue; } r -= I_IN;
            if (r < I_UQ) { const int kb = r / 24, nb = r % 24; const int n0 = 64 * nb, head = n0 / DQK, within = n0 % DQK;
                size_t dl, dh;
                if (within < DN) { dl = (size_t)(256 * (head / 2) + 128 * (head % 2) + within); dh = dl + 32; }
                else { dl = (size_t)(256 * (4 + head / 4) + 32 * (head % 4)); dh = dl + 128; }
                tr_item(w_uq, NH * DQK, 64 * kb, n0, WuqT, QL, dl, dh, q_norm_g, scr, lane); continue; } r -= I_UQ;
            if (r < I_UK) { const int kb = r / 16, nb = r % 16; tr_item(w_uk, NH * DN, 64 * kb, 64 * nb, WkvT, KVL, 64 * nb, 64 * nb + 32, kv_norm_g, scr, lane); continue; } r -= I_UK;
            if (r < I_UV) { const int kb = r / 16, nb = r % 16; tr_item(w_uv, NH * DV, 64 * kb, 64 * nb, WkvT, KVL, 1024 + 64 * nb, 1024 + 64 * nb + 32, kv_norm_g, scr, lane); continue; } r -= I_UV;
            { const int w = r / I_SQ, rr = r % I_SQ, kb = rr / 16, nb = rr % 16; const float* src = (w == 0) ? w_cb : (w == 1) ? w_ab : w_out; bf16_t* dst = (w == 0) ? WcbT : (w == 1) ? WabT : WoutT;
                tr_item(src, DM, 64 * kb, 64 * nb, dst, DM, 64 * nb, 64 * nb + 32, nullptr, scr, lane); }
        }
        for (int i = gt; i < (NPROJ - IN_DIM) * DM / 8; i += NGT) *(u32x4*)(WinT + (size_t)IN_DIM * DM + (size_t)i * 8) = (u32x4){0u, 0u, 0u, 0u};
        for (int i = gt; i < T * DM / 8; i += NGT) { const f32x4 a = *(const f32x4*)(x + (size_t)i * 8), b = *(const f32x4*)(x + (size_t)i * 8 + 4); *(u32x4*)(XB + (size_t)i * 8) = pg8::pack8(a, b); }
        for (int i = gt; i < T * 32; i += NGT) { const int t = i >> 5, f = i & 31; const float invf = powf(10000.0f, -(float)f / 32.0f); const float ang = (float)positions[t] * invf;
            float s, c; sincosf(ang, &s, &c); tab_cos[i] = c; tab_sin[i] = s; }
    }
    GRID_BAR(0);

    if (IN(1)) {
        pg8::Gemm g{XB, WinT, DM, DM}; pg8::StaticOrder S; S.init(T, NPROJ, G, bx);
        pg8::EpiProj E{PROJ, ssq_q, ssq_kv};
        pg8::gemm_phase<pg8::EpiProj, pg8::StaticOrder, true>(lds, g, S, E);
    }
    GRID_BAR(1);

    if (IN(2)) {
#ifndef DBG_P2
#define DBG_P2 15
#endif
        if (DBG_P2 & 1) { const int cg = (tid & 127) * 8, rs = tid >> 7;
          f32x4 w0a = *(const f32x4*)(conv_w + cg), w0b = *(const f32x4*)(conv_w + cg + 4), w1a = *(const f32x4*)(conv_w + DM + cg), w1b = *(const f32x4*)(conv_w + DM + cg + 4),
                w2a = *(const f32x4*)(conv_w + 2 * DM + cg), w2b = *(const f32x4*)(conv_w + 2 * DM + cg + 4);
          for (int it = vcu; it < T / 16; it += G) { const int t0 = it * 16 + rs * 4;
              f32x4 um2a = {0, 0, 0, 0}, um2b = um2a, um1a = um2a, um1b = um2a;
#pragma unroll
              for (int d = -2; d < 4; ++d) { const int t = t0 + d; f32x4 ua = {0, 0, 0, 0}, ub = ua;
                  if (d >= 0 || (t0 & (SEQ - 1)) + d >= 0) { const bf16_t* pr = PROJ + (size_t)t * NPROJ + cg;
                      f32x4 ga, gb_, ha, hb; pg8::unpack8(*(const u32x4*)(pr + OFF_GC), ga, gb_); pg8::unpack8(*(const u32x4*)(pr + OFF_HC), ha, hb); ua = ga * ha; ub = gb_ * hb; }
                  if (d >= 0) { const bf16_t* pr = PROJ + (size_t)t * NPROJ + cg; f32x4 ba, bb; pg8::unpack8(*(const u32x4*)(pr + OFF_GB), ba, bb);
                      const f32x4 ca = ba * (w0a * um2a + w1a * um1a + w2a * ua), cb = bb * (w0b * um2b + w1b * um1b + w2b * ub);
                      *(u32x4*)(CI + (size_t)t * DM + cg) = pg8::pack8(ca, cb); }
                  um2a = um1a; um2b = um1b; um1a = ua; um1b = ub; } } }
        if (DBG_P2 & 2) for (int i = gt; i < T * 32; i += NGT) { const int t = i >> 5, f = i & 31; const bf16_t* kp = PROJ + (size_t)t * NPROJ + OFF_KPE;
            const float k1 = __uint_as_float((unsigned)kp[f] << 16), k2 = __uint_as_float((unsigned)kp[f + 32] << 16), c = tab_cos[i], s = tab_sin[i];
            KPE[(size_t)t * DR + f] = (bf16_t)(pk_bf16(k1 * c - k2 * s, 0.f) & 0xffffu); KPE[(size_t)t * DR + f + 32] = (bf16_t)(pk_bf16(k1 * s + k2 * c, 0.f) & 0xffffu); }
        if (DBG_P2 & 4) { pg8::Gemm g{PROJ + OFF_QL, WuqT, NPROJ, QL}; pg8::StaticOrder S; S.init(T, NH * DQK, G, bx);
          pg8::EpiQ E{Qb, ssq_q, tab_cos, tab_sin};
          pg8::gemm_phase<pg8::EpiQ, pg8::StaticOrder, true>(lds, g, S, E); }
        if (DBG_P2 & 8) { pg8::Gemm g{PROJ + OFF_KVL, WkvT, NPROJ, KVL}; pg8::StaticOrder S; S.init(T, 2 * NH * DN, G, bx);
          pg8::EpiKV E{KNb, Vb, ssq_kv};
          pg8::gemm_phase<pg8::EpiKV, pg8::StaticOrder, true>(lds, g, S, E); }
    }
    GRID_BAR(2);

    if (IN(3)) {
#ifndef DBG_NO_YC
        { pg8::Gemm g{CI, WcbT, DM, DM}; pg8::StaticOrder S; S.init(T, DM, G, bx);
          pg8::EpiGate<false> E{YC, PROJ, OFF_GCONV, nullptr};
          pg8::gemm_phase<pg8::EpiGate<false>, pg8::StaticOrder, true>(lds, g, S, E); }
#endif
#ifndef DBG_NO_ATT
        for (int p = vcu; p < BATCH * NH * 8; p += G) { const int bh = p >> 3, s = p & 7;
            _Pragma("nounroll") for (int ui = 0; ui < 2; ++ui) att::attn_unit(bh / NH, bh % NH, ui ? s : 15 - s, Qb, KNb, KPE, Vb, AO, lds); }
#endif
    }
    GRID_BAR(3);

    if (IN(4)) {
        pg8::Gemm g{AO, WabT, DM, DM}; pg8::StaticOrder S; S.init(T, DM, G, bx);
        pg8::EpiGate<true> E{MG, PROJ, OFF_GATTN, YC};
        pg8::gemm_phase<pg8::EpiGate<true>, pg8::StaticOrder, true>(lds, g, S, E);
    }
    GRID_BAR(4);

    if (IN(5)) {
        pg8::Gemm g{MG, WoutT, DM, DM}; pg8::StaticOrder S; S.init(T, DM, G, bx);
        pg8::EpiH1 E{H1, x};
        pg8::gemm_phase<pg8::EpiH1, pg8::StaticOrder, true>(lds, g, S, E);
    }
    GRID_BAR(5);

    if (IN(6)) {
        LAS float* Wt = (LAS float*)lds;
        for (int i = tid; i < DM * NE / 4; i += 512) { const int k = i >> 3, q4 = (i & 7) * 4; const f32x4 v = *(const f32x4*)(w_router + (size_t)k * NE + q4);
            Wt[(q4 + 0) * DM + k] = v[0]; Wt[(q4 + 1) * DM + k] = v[1]; Wt[(q4 + 2) * DM + k] = v[2]; Wt[(q4 + 3) * DM + k] = v[3]; }
        LAS float* lsc = (LAS float*)(lds + MISC_OFF + 512) + wave * 32;
        __syncthreads();
        f32x4 gv[4], bv[4];
#pragma unroll
        for (int j = 0; j < 4; ++j) { gv[j] = *(const f32x4*)(ln1_g + 4 * lane + 256 * j); bv[j] = *(const f32x4*)(ln1_b + 4 * lane + 256 * j); }
        const float my_bias = b_router[lane >> 1];
        for (int t = gw; t < T; t += NGW) {
            f32x4 v[4]; float s = 0.f;
#pragma unroll
            for (int j = 0; j < 4; ++j) { v[j] = *(const f32x4*)(H1 + (size_t)t * DM + 4 * lane + 256 * j); s += (v[j][0] + v[j][1]) + (v[j][2] + v[j][3]); }
            const float mean = wave_sum(s) * (1.f / DM); float s2 = 0.f;
#pragma unroll
            for (int j = 0; j < 4; ++j) { v[j] = v[j] - mean; s2 += (v[j][0] * v[j][0] + v[j][1] * v[j][1]) + (v[j][2] * v[j][2] + v[j][3] * v[j][3]); }
            const float rstd = 1.f / sqrtf(wave_sum(s2) * (1.f / DM) + LN_EPS);
#pragma unroll
            for (int j = 0; j < 4; ++j) { v[j] = v[j] * rstd * gv[j] + bv[j];
                *(f32x4*)(X1F + (size_t)t * DM + 4 * lane + 256 * j) = v[j];
                u32x2 w; w.x = pk_bf16(v[j][0], v[j][1]); w.y = pk_bf16(v[j][2], v[j][3]); *(u32x2*)(X1B + (size_t)t * DM + 4 * lane + 256 * j) = w; }
            float p[32];
#pragma unroll
            for (int e = 0; e < 32; ++e) { float a = 0.f;
#pragma unroll
                for (int j = 0; j < 4; ++j) { const f32x4 w = *(const LAS f32x4*)(Wt + e * DM + 4 * lane + 256 * j); a += (v[j][0] * w[0] + v[j][1] * w[1]) + (v[j][2] * w[2] + v[j][3] * w[3]); }
                p[e] = a; }
#pragma unroll
            for (int w = 16; w >= 1; w >>= 1) { const bool up = (lane & (2 * w)) != 0;
#pragma unroll
                for (int i = 0; i < w; ++i) { const float mine = up ? p[i + w] : p[i], send = up ? p[i] : p[i + w]; p[i] = mine + __shfl_xor(send, 2 * w); } }
            float logit = p[0] + __shfl_xor(p[0], 1) + my_bias;
            if ((lane & 1) == 0) lsc[lane >> 1] = logit;
            LDS_WAIT(); asm volatile("" ::: "memory");
            float lg[32];
#pragma unroll
            for (int e = 0; e < 32; e += 4) { const f32x4 q = *(const LAS f32x4*)(lsc + e); lg[e] = q[0]; lg[e + 1] = q[1]; lg[e + 2] = q[2]; lg[e + 3] = q[3]; }
            LDS_WAIT(); asm volatile("" ::: "memory");
            int sel[4]; float sv[4];
#pragma unroll
            for (int k = 0; k < 4; ++k) { float best = -INFINITY; int bi = 0;
#pragma unroll
                for (int e = 0; e < 32; ++e) { const bool c = lg[e] > best; best = c ? lg[e] : best; bi = c ? e : bi; }
                sel[k] = bi; sv[k] = best;
#pragma unroll
                for (int e = 0; e < 32; ++e) lg[e] = (e == bi) ? -INFINITY : lg[e]; }
            const float e1 = __expf(sv[1] - sv[0]), e2 = __expf(sv[2] - sv[0]), e3 = __expf(sv[3] - sv[0]); const float inv = 1.f / (1.f + e1 + e2 + e3);
            if (lane < 4) { const int e = (lane == 0) ? sel[0] : (lane == 1) ? sel[1] : (lane == 2) ? sel[2] : sel[3];
                const float w = ((lane == 0) ? 1.f : (lane == 1) ? e1 : (lane == 2) ? e2 : e3) * inv;
                const int pos = (int)__hip_atomic_fetch_add(ecnt + 64 * e, 1u, RLX_AGENT);
                tope[(size_t)t * 4 + lane] = e; topw[(size_t)t * 4 + lane] = w; tpos[(size_t)t * 4 + lane] = pos;
                list[(size_t)e * LIST_CAP + pos] = t; }
        }
        __syncthreads();
    }
    GRID_BAR(6);

    if (IN(7) || IN(8) || IN(9)) {
        if (tid < NE) CNT[tid] = (int)__hip_atomic_load(ecnt + 64 * tid, RLX_AGENT);
        __syncthreads();
        if (tid == 0) { int acc = 0; for (int e = 0; e < NE; ++e) { TST[e] = acc; acc += (CNT[e] + 255) >> 8; } TST[NE] = acc; }
        __syncthreads();
    }
    const int nMt = (IN(7) || IN(8) || IN(9)) ? TST[NE] : 0;

    if (IN(7)) {
        pg8::Gemm g{X1B, WguT, DM, DM};
        pg8::MoeOrder<true> S; S.nM = nMt; S.nN = 2 * DFF / 256; S.nwg = S.nM * S.nN; S.G = G; S.c = bx; S.tstart = TST; S.cnt = CNT; S.list = list;
        pg8::EpiGU E{HID, b_gu};
        pg8::gemm_phase<pg8::EpiGU, pg8::MoeOrder<true>, true>(lds, g, S, E);
    }
    GRID_BAR(7);

    if (IN(8)) {
        pg8::Gemm g{HID, WdT, DFF, DFF};
        pg8::MoeOrder<false> S; S.nM = nMt; S.nN = DM / 256; S.nwg = S.nM * S.nN; S.G = G; S.c = bx; S.tstart = TST; S.cnt = CNT; S.list = list;
        pg8::EpiDown E{EO, b_dn};
        pg8::gemm_phase<pg8::EpiDown, pg8::MoeOrder<false>, true>(lds, g, S, E);
    }
    GRID_BAR(8);

    if (IN(9)) {
        f32x4 gv[4], bv[4];
#pragma unroll
        for (int j = 0; j < 4; ++j) { gv[j] = *(const f32x4*)(ln2_g + 4 * lane + 256 * j); bv[j] = *(const f32x4*)(ln2_b + 4 * lane + 256 * j); }
        for (int t = gw; t < T; t += NGW) {
            int myrow = 0; float myw = 0.f;
            if (lane < 4) { const int e = tope[(size_t)t * 4 + lane]; myrow = TST[e] * 256 + tpos[(size_t)t * 4 + lane]; myw = topw[(size_t)t * 4 + lane]; }
            f32x4 v[4];
#pragma unroll
            for (int j = 0; j < 4; ++j) v[j] = *(const f32x4*)(X1F + (size_t)t * DM + 4 * lane + 256 * j) * DN_ALPHA;
#pragma unroll
            for (int k = 0; k < 4; ++k) { const int row = __builtin_amdgcn_readlane(myrow, k); const float w = __builtin_bit_cast(float, __builtin_amdgcn_readlane(__builtin_bit_cast(int, myw), k));
#pragma unroll
                for (int j = 0; j < 4; ++j) { const u32x2 q = *(const u32x2*)(EO + (size_t)row * DM + 4 * lane + 256 * j);
                    v[j][0] += w * bf_lo(q.x); v[j][1] += w * bf_hi(q.x); v[j][2] += w * bf_lo(q.y); v[j][3] += w * bf_hi(q.y); } }
            float s = 0.f;
#pragma unroll
            for (int j = 0; j < 4; ++j) s += (v[j][0] + v[j][1]) + (v[j][2] + v[j][3]);
            const float mean = wave_sum(s) * (1.f / DM); float s2 = 0.f;
#pragma unroll
            for (int j = 0; j < 4; ++j) { v[j] = v[j] - mean; s2 += (v[j][0] * v[j][0] + v[j][1] * v[j][1]) + (v[j][2] * v[j][2] + v[j][3] * v[j][3]); }
            const float rstd = 1.f / sqrtf(wave_sum(s2) * (1.f / DM) + LN_EPS);
#pragma unroll
            for (int j = 0; j < 4; ++j) *(f32x4*)(out + (size_t)t * DM + 4 * lane + 256 * j) = v[j] * rstd * gv[j] + bv[j];
        }
    }
#undef IN
#undef GRID_BAR
}

extern "C" void kernel_launch(void* const* d_in, const int* in_sizes, int n_in, void* d_out, int out_size, void* d_ws, size_t ws_size, hipStream_t stream) {
    static int grid = 0;
    if (grid == 0) {
        if (n_in != 22 || in_sizes[0] != T * DM || out_size != T * DM || ws_size < WS_END) {
            fprintf(stderr, "kernel_launch: shape mismatch: n_in %d in0 %d out %d ws %zu (need %zu)\n", n_in, n_in > 0 ? in_sizes[0] : -1, out_size, ws_size, (size_t)WS_END); grid = -1; return; }
        int dev = 0, cus = 0, per_cu = 0;
        if (hipGetDevice(&dev) != hipSuccess || hipDeviceGetAttribute(&cus, hipDeviceAttributeMultiprocessorCount, dev) != hipSuccess) { fprintf(stderr, "kernel_launch: device query failed\n"); grid = -1; return; }
        if (hipFuncSetAttribute((const void*)mk_fwd, hipFuncAttributeMaxDynamicSharedMemorySize, LDS_BYTES) != hipSuccess) { fprintf(stderr, "kernel_launch: hipFuncSetAttribute failed\n"); grid = -1; return; }
        if (hipOccupancyMaxActiveBlocksPerMultiprocessor(&per_cu, (const void*)mk_fwd, 512, LDS_BYTES) != hipSuccess || per_cu < 1) {
            fprintf(stderr, "kernel_launch: occupancy query reports %d blocks per CU\n", per_cu); (void)hipGetLastError(); grid = -1; return; }
        (void)hipGetLastError();
        grid = cus;
    }
    if (grid < 0) return;
    if (hipMemsetAsync((char*)d_ws + WS_CTL, 0, CTL_ZERO_BYTES, stream) != hipSuccess) { fprintf(stderr, "kernel_launch: memset failed\n"); return; }
    Args a{};
    for (int i = 0; i < 22; ++i) a.in[i] = d_in[i];
    a.out = (float*)d_out; a.ws = (unsigned char*)d_ws;
    for (int li = 0; li < N_LAUNCHES; ++li) {
        a.ph_lo = (N_LAUNCHES == 1) ? 0 : li; a.ph_hi = (N_LAUNCHES == 1) ? N_PHASES : li + 1;
        hipLaunchKernelGGL(mk_fwd, dim3(grid), dim3(512), LDS_BYTES, stream, a);
        const hipError_t le = hipPeekAtLastError();
        if (le != hipSuccess) { fprintf(stderr, "kernel_launch: launch %d failed: %s\n", li, hipGetErrorName(le)); break; }
    }
}
```

```cpp
#include <hip/hip_runtime.h>
#include <cstdio>
#include <cstdint>

#define GAS __attribute__((address_space(1)))
#define LAS __attribute__((address_space(3)))
typedef unsigned short bf16_t;
typedef short bf16x8 __attribute__((ext_vector_type(8)));
typedef short s16x4 __attribute__((ext_vector_type(4)));
typedef float f32x4 __attribute__((ext_vector_type(4)));
typedef float f32x2 __attribute__((ext_vector_type(2)));
typedef float f32x16 __attribute__((ext_vector_type(16)));
typedef unsigned u32x4 __attribute__((ext_vector_type(4)));
typedef unsigned u32x2 __attribute__((ext_vector_type(2)));

#ifndef MK_N_LAUNCHES
#define MK_N_LAUNCHES 1
#endif
constexpr int N_PHASES = 10;
constexpr int N_LAUNCHES = MK_N_LAUNCHES;
static_assert(N_LAUNCHES == 1 || N_LAUNCHES == N_PHASES, "MK_N_LAUNCHES is 1 or 10");

constexpr int BATCH = 4, SEQ = 4096, DM = 1024, T = BATCH * SEQ;
constexpr int NH = 8, DN = 128, DR = 64, DQK = 192, DV = 128, QL = 384, KVL = 256;
constexpr int NE = 32, DFF = 1024;
constexpr int IN_DIM = 5824, NPROJ = 5888;
constexpr int OFF_GB = 0, OFF_GC = 1024, OFF_HC = 2048, OFF_QL = 3072, OFF_KVL = 3456, OFF_KPE = 3712, OFF_GCONV = 3776, OFF_GATTN = 4800;
constexpr float LN_EPS = 1e-5f, RMS_EPS = 1e-6f, DN_ALPHA = 1.1892071150027210667f, SWI_LIMIT = 7.0f, SWI_ALPHA = 1.702f;
constexpr float LOG2E = 1.4426950408889634f;
constexpr float QSCALE = 0.07216878364870323f * LOG2E;
constexpr int LIST_CAP = T;
constexpr int MAX_MT = T * 4 / 256 + NE;

constexpr size_t MiB = 1u << 20;
constexpr size_t WS_CTL = 0, CTL_ZERO_BYTES = 1 * MiB;
constexpr size_t WS_SSQ = 256 * 1024;
constexpr size_t WS_XB = 1 * MiB;
constexpr size_t WS_WIN = 33 * MiB;
constexpr size_t WS_WUQ = 45 * MiB;
constexpr size_t WS_WKV = 47 * MiB;
constexpr size_t WS_WCB = 48 * MiB, WS_WAB = 50 * MiB, WS_WOUT = 52 * MiB;
constexpr size_t WS_TAB = 54 * MiB;
constexpr size_t WS_KPE = 58 * MiB;
constexpr size_t WS_TOP = 60 * MiB;
constexpr size_t WS_LIST = 61 * MiB;
constexpr size_t WS_WGU = 64 * MiB;
constexpr size_t WS_WD = 192 * MiB;
constexpr size_t WS_PROJ = 256 * MiB;
constexpr size_t WS_HID = WS_PROJ;
constexpr size_t WS_Q = 440 * MiB;
constexpr size_t WS_KN = 488 * MiB, WS_V = 520 * MiB, WS_CI = 552 * MiB;
constexpr size_t WS_EO = WS_Q;
constexpr size_t WS_YC = 584 * MiB, WS_AO = 616 * MiB, WS_MG = 648 * MiB;
constexpr size_t WS_H1 = 680 * MiB;
constexpr size_t WS_X1F = 744 * MiB;
constexpr size_t WS_X1B = 808 * MiB;
constexpr size_t WS_END = 840 * MiB;
static_assert(WS_HID + (size_t)MAX_MT * 256 * DFF * 2 <= WS_Q && WS_EO + (size_t)MAX_MT * 256 * DM * 2 <= WS_YC, "overlay map");
constexpr int CW_TMO = 0;
constexpr int CW_BAR = 4096;
constexpr int CW_CNT = 8192;

constexpr int RING_BYTES = 131072;
constexpr int MISC_OFF = 139264;
constexpr int LDS_BYTES = 147456;

#define LDS_WAIT() asm volatile("s_waitcnt lgkmcnt(0)" ::: "memory")
#define VM_WAIT() asm volatile("s_waitcnt vmcnt(0)" ::: "memory")
#define RLX_AGENT __ATOMIC_RELAXED, __HIP_MEMORY_SCOPE_AGENT

__device__ __forceinline__ unsigned pk_bf16(float lo, float hi) {
    typedef __bf16 b2 __attribute__((ext_vector_type(2)));
    f32x2 v = {lo, hi}; b2 b = __builtin_convertvector(v, b2); return __builtin_bit_cast(unsigned, b);
}
__device__ __forceinline__ float bf_lo(unsigned w) { return __uint_as_float(w << 16); }
__device__ __forceinline__ float bf_hi(unsigned w) { return __uint_as_float(w & 0xffff0000u); }
__device__ __forceinline__ float sigmoidf_(float x) { return __builtin_amdgcn_rcpf(1.0f + __builtin_amdgcn_exp2f(-x * LOG2E)); }
__device__ __forceinline__ float wave_sum(float v) {
#pragma unroll
    for (int o = 1; o < 64; o <<= 1) v += __shfl_xor(v, o);
    return v;
}

namespace pg8 {
constexpr int BM = 256, BK = 64, HALF = 128, HTB = HALF * BK * 2, STAGE_BYTES = 8 * HTB, NXCD = 8, WGM = 8;
__device__ __forceinline__ int lds_byte(int r, int c) { const int st = (r >> 4) * 2 + (c >> 5), rr = r & 15, cc = c & 31, ob = rr * 64 + cc * 2; return st * 1024 + (ob ^ (((ob >> 9) & 1) << 5)); }
__device__ __forceinline__ void stage_rc(int b, int& R, int& C) { const int st = b / 1024, sb = b % 1024, swz = sb ^ (((sb >> 9) & 1) << 5); R = (st >> 1) * 16 + swz / 64; C = (st & 1) * 32 + (swz % 64) / 2; }
__device__ __forceinline__ int perm32(int rho) { const int n = rho >> 4, i = rho & 15; return 8 * (i >> 2) + 4 * n + (i & 3); }

struct Unit { int pm, pn, pb, e; };
struct Gemm { const bf16_t* A; const bf16_t* Bt; int lda; int K; };

__device__ __forceinline__ void tile_of(int L, int nM, int nN, int& pm, int& pn) {
    const int nwg = nM * nN; int wgid = L;
    { const int q = nwg / NXCD, r = nwg % NXCD, xcd = wgid % NXCD, off = wgid / NXCD; wgid = (xcd < r ? xcd * (q + 1) : r * (q + 1) + (xcd - r) * q) + off; }
    const int nig = WGM * nN, gid = wgid / nig, fm = gid * WGM, gsz = (nM - fm) < WGM ? (nM - fm) : WGM;
    pm = fm + ((wgid % nig) % gsz); pn = (wgid % nig) / gsz;
}
struct StaticOrder {
    int nM, nN, nwg, G, c;
    __device__ void init(int M, int N, int G_, int c_) { nM = M / BM; nN = N / BM; nwg = nM * nN; G = G_; c = c_; }
    __device__ __forceinline__ bool next(int i, Unit& u) const {
        const long L = (long)i * G + c; if (L >= nwg) return false;
        tile_of((int)L, nM, nN, u.pm, u.pn); u.pb = u.pn; u.e = 0; return true;
    }
    __device__ __forceinline__ int arow(const Unit& u, int r) const { return u.pm * BM + r; }
};
template <bool GATHER> struct MoeOrder {
    int nM, nN, nwg, G, c; const volatile LAS int* tstart; const volatile LAS int* cnt; const int* list;
    __device__ __forceinline__ bool next(int i, Unit& u) const {
        const long L = (long)i * G + c; if (L >= nwg) return false;
        tile_of((int)L, nM, nN, u.pm, u.pn);
        int e = 0;
        for (int j = 1; j < NE; ++j) e += (tstart[j] <= u.pm) ? 1 : 0;
        u.e = e; u.pb = e * nN + u.pn; return true;
    }
    __device__ __forceinline__ int arow(const Unit& u, int r) const {
        if (!GATHER) return u.pm * BM + r;
        const int pos = (u.pm - tstart[u.e]) * BM + r;
        return pos < cnt[u.e] ? list[(size_t)u.e * LIST_CAP + pos] : 0;
    }
};

template <class Epi, class Sched, bool ALIGN_EPI>
__device__ __forceinline__ void gemm_phase(LAS unsigned char* lds, const Gemm g, const Sched& S, const Epi& E) {
    const int tid = threadIdx.x, wid = __builtin_amdgcn_readfirstlane(tid >> 6), lane = tid & 63, wr = wid >> 2, wc = wid & 3, fr = lane & 15, fq = lane >> 4;
    const int K = g.K, nt = K / BK, lda = g.lda;
    int Rr[2], Cc[2]; unsigned voffB[2];
#pragma unroll
    for (int i = 0; i < 2; ++i) { stage_rc(tid * 16 + i * 8192, Rr[i], Cc[i]); const int Rb = Epi::PERM ? ((Rr[i] & ~31) + perm32(Rr[i] & 31)) : Rr[i]; voffB[i] = (unsigned)(Rb * K + Cc[i]) * 2u; }
    const size_t kstep = (size_t)(BK * 2);
    const size_t hstepB = (size_t)HALF * K * 2, tstepB = 2 * hstepB;
    const unsigned ldsw = (unsigned)wid * 1024u;
    const int aoff = lds_byte(wr * 64 + fr, fq * 8), boff = lds_byte(wc * 32 + fr, fq * 8);
#define PG8_SA(b, h) (((b) * 2 + (h)) * HTB)
#define PG8_SB(b, h) ((4 + (b) * 2 + (h)) * HTB)
#define PG8_STAGE(bufoff, gbase, voff) do { _Pragma("unroll") for (int _i = 0; _i < 2; ++_i) \
        __builtin_amdgcn_global_load_lds((const unsigned*)((const char*)(gbase) + (voff)[_i]), (LAS unsigned*)(lds + (bufoff) + ldsw + _i * 8192), 16, 0, 0); } while (0)
#define PG8_LDA(dst, b, h) do { _Pragma("unroll") for (int m = 0; m < 4; ++m) _Pragma("unroll") for (int k = 0; k < 2; ++k) dst[m][k] = *(const LAS bf16x8*)(lds + PG8_SA(b, h) + aoff + m * 2048 + k * 1024); } while (0)
#define PG8_LDB(dst, b, h) do { _Pragma("unroll") for (int n = 0; n < 2; ++n) _Pragma("unroll") for (int k = 0; k < 2; ++k) dst[n][k] = *(const LAS bf16x8*)(lds + PG8_SB(b, h) + boff + n * 2048 + k * 1024); } while (0)
#define PG8_MMA(ai, bj, At, Bt) do { __builtin_amdgcn_s_setprio(1); _Pragma("unroll") for (int m = 0; m < 4; ++m) _Pragma("unroll") for (int n = 0; n < 2; ++n) _Pragma("unroll") for (int k = 0; k < 2; ++k) \
        acc[ai][bj][m][n] = __builtin_amdgcn_mfma_f32_16x16x32_bf16(Bt[n][k], At[m][k], acc[ai][bj][m][n], 0, 0, 0); __builtin_amdgcn_s_setprio(0); } while (0)
#define PG8_WAIT_V(n) asm volatile("s_waitcnt vmcnt(" #n ")" ::: "memory")
#define PG8_WAIT_L(n) asm volatile("s_waitcnt lgkmcnt(" #n ")" ::: "memory")
#define PG8_BAR __builtin_amdgcn_s_barrier()
#define PG8_SCHED __builtin_amdgcn_sched_barrier(0)
#define PG8_AOFF(dst, u) do { _Pragma("unroll") for (int _h = 0; _h < 2; ++_h) _Pragma("unroll") for (int _i = 0; _i < 2; ++_i) \
        dst[_h][_i] = ((unsigned)S.arow(u, _h * HALF + Rr[_i]) * (unsigned)lda + (unsigned)Cc[_i]) * 2u; } while (0)
    Unit cur, nxt; int ui = 0;
    if (!S.next(0, cur)) return;
    f32x4 acc[2][2][4][2];
#pragma unroll
    for (int a = 0; a < 2; ++a)
#pragma unroll
        for (int b = 0; b < 2; ++b)
#pragma unroll
            for (int m = 0; m < 4; ++m)
#pragma unroll
                for (int n = 0; n < 2; ++n) acc[a][b][m][n] = (f32x4){0.f, 0.f, 0.f, 0.f};
    bf16x8 At[4][2], B0[2][2], B1[2][2];
    unsigned vA[2][2], vN[2][2];
    PG8_AOFF(vA, cur);
    const char* const gA = (const char*)g.A;
    const char* cB = (const char*)g.Bt + (size_t)cur.pb * tstepB;
    PG8_STAGE(PG8_SB(0, 0), cB, voffB); PG8_STAGE(PG8_SB(0, 1), cB + hstepB, voffB); PG8_STAGE(PG8_SA(0, 0), gA, vA[0]); PG8_STAGE(PG8_SA(0, 1), gA, vA[1]);
    if (wr == 1) PG8_BAR;
    PG8_WAIT_V(2); PG8_BAR;
    PG8_STAGE(PG8_SB(1, 0), cB + kstep, voffB); PG8_STAGE(PG8_SA(1, 0), gA + kstep, vA[0]); PG8_STAGE(PG8_SB(1, 1), cB + hstepB + kstep, voffB);
    PG8_WAIT_V(6); PG8_BAR;
    for (;;) {
        const bool has_next = S.next(ui + 1, nxt);
        const char* nB = has_next ? (const char*)g.Bt + (size_t)nxt.pb * tstepB : cB;
        if (has_next) { PG8_AOFF(vN, nxt); } else {
#pragma unroll
            for (int h = 0; h < 2; ++h)
#pragma unroll
                for (int i = 0; i < 2; ++i) vN[h][i] = vA[h][i]; }
        _Pragma("nounroll") for (int t = 0; t < nt; t += 2) {
            const bool last = (t == nt - 2);
            const char* a1 = gA + (size_t)(t + 1) * kstep;
            const char* a2 = last ? gA : gA + (size_t)(t + 2) * kstep; const char* b2 = last ? nB : cB + (size_t)(t + 2) * kstep;
            const char* a3 = a2 + kstep; const char* b3 = b2 + kstep;
            unsigned v2[2][2];
#pragma unroll
            for (int h = 0; h < 2; ++h)
#pragma unroll
                for (int i = 0; i < 2; ++i) v2[h][i] = last ? vN[h][i] : vA[h][i];
            PG8_LDB(B0, 0, 0); PG8_LDB(B1, 0, 1); PG8_SCHED; PG8_LDA(At, 0, 0); PG8_STAGE(PG8_SA(1, 1), a1, vA[1]);
            PG8_WAIT_V(8); PG8_WAIT_L(0); PG8_BAR; PG8_MMA(0, 0, At, B0); PG8_MMA(0, 1, At, B1); PG8_BAR; PG8_SCHED;
            PG8_LDA(At, 0, 1); PG8_STAGE(PG8_SB(0, 0), b2, voffB); PG8_STAGE(PG8_SB(0, 1), b2 + hstepB, voffB); PG8_STAGE(PG8_SA(0, 0), a2, v2[0]);
            PG8_WAIT_V(8); PG8_WAIT_L(0); PG8_BAR; PG8_MMA(1, 0, At, B0); PG8_MMA(1, 1, At, B1); PG8_BAR; PG8_SCHED;
            PG8_LDB(B0, 1, 0); PG8_LDB(B1, 1, 1); PG8_SCHED; PG8_LDA(At, 1, 0); PG8_STAGE(PG8_SA(0, 1), a2, v2[1]);
            PG8_WAIT_V(8); PG8_WAIT_L(0); PG8_BAR; PG8_MMA(0, 0, At, B0); PG8_MMA(0, 1, At, B1); PG8_BAR; PG8_SCHED;
            PG8_LDA(At, 1, 1); PG8_STAGE(PG8_SB(1, 0), b3, voffB); PG8_STAGE(PG8_SB(1, 1), b3 + hstepB, voffB); PG8_STAGE(PG8_SA(1, 0), a3, v2[0]);
            PG8_WAIT_V(8); PG8_WAIT_L(0); PG8_BAR; PG8_MMA(1, 0, At, B0); PG8_MMA(1, 1, At, B1); PG8_BAR; PG8_SCHED;
        }
        if constexpr (ALIGN_EPI) { if (wr == 0) PG8_BAR; }
        E(acc, cur, wr, wc, fr, fq);
        if (!has_next) break;
#pragma unroll
        for (int a = 0; a < 2; ++a)
#pragma unroll
            for (int b = 0; b < 2; ++b)
#pragma unroll
                for (int m = 0; m < 4; ++m)
#pragma unroll
                    for (int n = 0; n < 2; ++n) acc[a][b][m][n] = (f32x4){0.f, 0.f, 0.f, 0.f};
        cur = nxt; cB = nB; ++ui;
#pragma unroll
        for (int h = 0; h < 2; ++h)
#pragma unroll
            for (int i = 0; i < 2; ++i) vA[h][i] = vN[h][i];
        if constexpr (ALIGN_EPI) { if (wr == 1) PG8_BAR; }
    }
    PG8_WAIT_V(0);
    if constexpr (!ALIGN_EPI) { if (wr == 0) PG8_BAR; }
    PG8_BAR;
#undef PG8_SA
#undef PG8_SB
#undef PG8_STAGE
#undef PG8_LDA
#undef PG8_LDB
#undef PG8_MMA
#undef PG8_WAIT_V
#undef PG8_WAIT_L
#undef PG8_BAR
#undef PG8_SCHED
#undef PG8_AOFF
}

typedef const f32x4 (&AccRef)[2][2][4][2];
__device__ __forceinline__ u32x4 pack8(f32x4 a, f32x4 b) { u32x4 w; w.x = pk_bf16(a[0], a[1]); w.y = pk_bf16(a[2], a[3]); w.z = pk_bf16(b[0], b[1]); w.w = pk_bf16(b[2], b[3]); return w; }
__device__ __forceinline__ void unpack8(u32x4 w, f32x4& a, f32x4& b) { a = (f32x4){bf_lo(w.x), bf_hi(w.x), bf_lo(w.y), bf_hi(w.y)}; b = (f32x4){bf_lo(w.z), bf_hi(w.z), bf_lo(w.w), bf_hi(w.w)}; }

struct EpiProj {
    static constexpr bool PERM = true;
    bf16_t* P; float* ssq_q; float* ssq_kv;
    __device__ __forceinline__ void operator()(AccRef acc, const Unit& u, int wr, int wc, int fr, int fq) const {
        const int row0 = u.pm * BM + wr * 64 + fr, col0 = u.pn * BM + wc * 32 + 8 * fq;
#pragma unroll
        for (int ai = 0; ai < 2; ++ai)
#pragma unroll
            for (int m = 0; m < 4; ++m) { bf16_t* rowp = P + (size_t)(row0 + ai * HALF + m * 16) * NPROJ + col0;
#pragma unroll
                for (int bj = 0; bj < 2; ++bj) *(u32x4*)(rowp + bj * HALF) = pack8(acc[ai][bj][m][0], acc[ai][bj][m][1]); }
#pragma unroll
        for (int bj = 0; bj < 2; ++bj) { const int hh = 2 * u.pn + bj;
            if (hh >= OFF_QL / 128 && hh < OFF_KPE / 128) { float* dst = (hh < OFF_KVL / 128) ? ssq_q : ssq_kv;
#pragma unroll
                for (int ai = 0; ai < 2; ++ai)
#pragma unroll
                    for (int m = 0; m < 4; ++m) { const f32x4 a = acc[ai][bj][m][0], b = acc[ai][bj][m][1];
                        float s = (a[0] * a[0] + a[1] * a[1]) + (a[2] * a[2] + a[3] * a[3]) + (b[0] * b[0] + b[1] * b[1]) + (b[2] * b[2] + b[3] * b[3]);
                        s += __shfl_xor(s, 16); s += __shfl_xor(s, 32);
                        if (fq == 0) atomicAdd(dst + row0 + ai * HALF + m * 16, s); } } }
    }
};
struct EpiQ {
    static constexpr bool PERM = true;
    bf16_t* Q; const float* ssq; const float* cs; const float* sn;
    __device__ __forceinline__ void operator()(AccRef acc, const Unit& u, int wr, int wc, int fr, int fq) const {
        const int row0 = u.pm * BM + wr * 64 + fr;
        if (u.pn < 4) {
#pragma unroll
            for (int ai = 0; ai < 2; ++ai)
#pragma unroll
                for (int m = 0; m < 4; ++m) { const int row = row0 + ai * HALF + m * 16;
                    const float rs = __builtin_amdgcn_rsqf(ssq[row] * (1.0f / QL) + RMS_EPS) * QSCALE;
#pragma unroll
                    for (int bj = 0; bj < 2; ++bj) { bf16_t* dst = Q + (size_t)row * (NH * DQK) + (2 * u.pn + bj) * DQK + wc * 32 + 8 * fq;
                        *(u32x4*)dst = pack8(acc[ai][bj][m][0] * rs, acc[ai][bj][m][1] * rs); } }
        } else {
            const int head = 4 * (u.pn - 4) + wc, i0 = 8 * fq;
#pragma unroll
            for (int ai = 0; ai < 2; ++ai)
#pragma unroll
                for (int m = 0; m < 4; ++m) { const int row = row0 + ai * HALF + m * 16;
                    const float rs = __builtin_amdgcn_rsqf(ssq[row] * (1.0f / QL) + RMS_EPS) * QSCALE;
                    const f32x4 c0 = *(const f32x4*)(cs + (size_t)row * 32 + i0), c1 = *(const f32x4*)(cs + (size_t)row * 32 + i0 + 4);
                    const f32x4 s0 = *(const f32x4*)(sn + (size_t)row * 32 + i0), s1 = *(const f32x4*)(sn + (size_t)row * 32 + i0 + 4);
                    const f32x4 x10 = acc[ai][0][m][0] * rs, x11 = acc[ai][0][m][1] * rs, x20 = acc[ai][1][m][0] * rs, x21 = acc[ai][1][m][1] * rs;
                    bf16_t* dst = Q + (size_t)row * (NH * DQK) + head * DQK + DN + i0;
                    *(u32x4*)dst = pack8(x10 * c0 - x20 * s0, x11 * c1 - x21 * s1);
                    *(u32x4*)(dst + 32) = pack8(x10 * s0 + x20 * c0, x11 * s1 + x21 * c1);
                    asm volatile("" ::: "memory"); }
        }
    }
};
struct EpiKV {
    static constexpr bool PERM = true;
    bf16_t* KN; bf16_t* V; const float* ssq;
    __device__ __forceinline__ void operator()(AccRef acc, const Unit& u, int wr, int wc, int fr, int fq) const {
        const int row0 = u.pm * BM + wr * 64 + fr; bf16_t* base = (u.pn < 4) ? KN : V; const int col0 = (u.pn & 3) * BM + wc * 32 + 8 * fq;
#pragma unroll
        for (int ai = 0; ai < 2; ++ai)
#pragma unroll
            for (int m = 0; m < 4; ++m) { const int row = row0 + ai * HALF + m * 16;
                const float rs = __builtin_amdgcn_rsqf(ssq[row] * (1.0f / KVL) + RMS_EPS);
#pragma unroll
                for (int bj = 0; bj < 2; ++bj) *(u32x4*)(base + (size_t)row * 1024 + col0 + bj * HALF) = pack8(acc[ai][bj][m][0] * rs, acc[ai][bj][m][1] * rs); }
    }
};
template <bool MERGE> struct EpiGate {
    static constexpr bool PERM = true;
    bf16_t* O; const bf16_t* P; int goff; const bf16_t* YC;
    __device__ __forceinline__ void operator()(AccRef acc, const Unit& u, int wr, int wc, int fr, int fq) const {
        const int row0 = u.pm * BM + wr * 64 + fr, col0 = u.pn * BM + wc * 32 + 8 * fq;
#pragma unroll
        for (int ai = 0; ai < 2; ++ai)
#pragma unroll
            for (int m = 0; m < 4; ++m) { const size_t row = (size_t)(row0 + ai * HALF + m * 16);
#pragma unroll
                for (int bj = 0; bj < 2; ++bj) { const int col = col0 + bj * HALF;
                    const u32x4 gw = *(const u32x4*)(P + row * NPROJ + goff + col); f32x4 g0, g1; unpack8(gw, g0, g1);
                    f32x4 v0 = acc[ai][bj][m][0], v1 = acc[ai][bj][m][1];
#pragma unroll
                    for (int j = 0; j < 4; ++j) { v0[j] *= sigmoidf_(g0[j]); v1[j] *= sigmoidf_(g1[j]); }
                    if (MERGE) { const u32x4 yw = *(const u32x4*)(YC + row * DM + col); f32x4 y0, y1; unpack8(yw, y0, y1); v0 += y0; v1 += y1; }
                    *(u32x4*)(O + row * DM + col) = pack8(v0, v1); } }
    }
};
struct EpiH1 {
    static constexpr bool PERM = false;
    float* H; const float* X;
    __device__ __forceinline__ void operator()(AccRef acc, const Unit& u, int wr, int wc, int fr, int fq) const {
        const int row0 = u.pm * BM + wr * 64 + fr, col0 = u.pn * BM + wc * 32 + 4 * fq;
#pragma unroll
        for (int ai = 0; ai < 2; ++ai)
#pragma unroll
            for (int m = 0; m < 4; ++m) { const size_t off = (size_t)(row0 + ai * HALF + m * 16) * DM + col0;
#pragma unroll
                for (int bj = 0; bj < 2; ++bj)
#pragma unroll
                    for (int n = 0; n < 2; ++n) { const f32x4 x = *(const f32x4*)(X + off + bj * HALF + n * 16); *(f32x4*)(H + off + bj * HALF + n * 16) = x * DN_ALPHA + acc[ai][bj][m][n]; } }
    }
};
struct EpiGU {
    static constexpr bool PERM = true;
    bf16_t* HID; const float* bias;
    __device__ __forceinline__ void operator()(AccRef acc, const Unit& u, int wr, int wc, int fr, int fq) const {
        const int row0 = u.pm * BM + wr * 64 + fr, c0 = u.pn * HALF + wc * 32 + 8 * fq;
        const float* bg = bias + (size_t)u.e * (2 * DFF) + c0;
        const f32x4 bg0 = *(const f32x4*)bg, bg1 = *(const f32x4*)(bg + 4), bu0 = *(const f32x4*)(bg + DFF), bu1 = *(const f32x4*)(bg + DFF + 4);
#pragma unroll
        for (int ai = 0; ai < 2; ++ai)
#pragma unroll
            for (int m = 0; m < 4; ++m) { f32x4 g0 = acc[ai][0][m][0] + bg0, g1 = acc[ai][0][m][1] + bg1, u0 = acc[ai][1][m][0] + bu0, u1 = acc[ai][1][m][1] + bu1;
#pragma unroll
                for (int j = 0; j < 4; ++j) {
                    float g = fminf(g0[j], SWI_LIMIT), up = fminf(fmaxf(u0[j], -SWI_LIMIT), SWI_LIMIT); g0[j] = (up + 1.0f) * (g * sigmoidf_(SWI_ALPHA * g));
                    g = fminf(g1[j], SWI_LIMIT); up = fminf(fmaxf(u1[j], -SWI_LIMIT), SWI_LIMIT); g1[j] = (up + 1.0f) * (g * sigmoidf_(SWI_ALPHA * g)); }
                *(u32x4*)(HID + (size_t)(row0 + ai * HALF + m * 16) * DFF + c0) = pack8(g0, g1); }
    }
};
struct EpiDown {
    static constexpr bool PERM = true;
    bf16_t* EO; const float* bias;
    __device__ __forceinline__ void operator()(AccRef acc, const Unit& u, int wr, int wc, int fr, int fq) const {
        const int row0 = u.pm * BM + wr * 64 + fr, col0 = u.pn * BM + wc * 32 + 8 * fq;
        f32x4 bv[2][2];
#pragma unroll
        for (int bj = 0; bj < 2; ++bj)
#pragma unroll
            for (int n = 0; n < 2; ++n) bv[bj][n] = *(const f32x4*)(bias + (size_t)u.e * DM + col0 + bj * HALF + 4 * n);
#pragma unroll
        for (int ai = 0; ai < 2; ++ai)
#pragma unroll
            for (int m = 0; m < 4; ++m) { bf16_t* rowp = EO + (size_t)(row0 + ai * HALF + m * 16) * DM + col0;
#pragma unroll
                for (int bj = 0; bj < 2; ++bj) *(u32x4*)(rowp + bj * HALF) = pack8(acc[ai][bj][m][0] + bv[bj][0], acc[ai][bj][m][1] + bv[bj][1]); }
    }
};
}

namespace att {
constexpr int NW = 8, QBLK = 32, KVBLK = 64;
constexpr int LDQ = NH * DQK, LDK = NH * DN, LDP = DR, LDO = NH * DV;
constexpr int SHM_V = KVBLK * DV * 2, SHM_KN = KVBLK * DN * 2, SHM_KP = KVBLK * DR * 2;
constexpr int OFF_V = 0, OFF_KN = 2 * SHM_V, OFF_KP = OFF_KN + 2 * SHM_KN, OFF_WS = OFF_KP + 2 * SHM_KP, ATT_LDS = OFF_WS + NW * 64 * 4;
static_assert(ATT_LDS <= RING_BYTES && MISC_OFF + 768 + 2048 <= LDS_BYTES && 8 * 16896 <= MISC_OFF, "LDS map");
constexpr float THR = 8.0f;
#define KSWZ(row, colB) ((row) * 256 + ((colB) ^ (((row) & 7) << 4)))
#define PSWZ(row, colB) ((row) * 128 + ((colB) ^ (((row) & 7) << 4)))
#define SBAR() __builtin_amdgcn_sched_barrier(0)
__device__ __forceinline__ int crow(int r, int hi) { return (r & 3) + 8 * (r >> 2) + 4 * hi; }

__device__ __forceinline__ void partialSM(f32x16& p0, f32x16& p1, float& m_reg, float& mn, float& alpha) {
    float pmax = p0[0];
#pragma unroll
    for (int r = 1; r < 16; ++r) pmax = fmaxf(pmax, p0[r]);
#pragma unroll
    for (int r = 0; r < 16; ++r) pmax = fmaxf(pmax, p1[r]);
    { auto rr = __builtin_amdgcn_permlane32_swap(__float_as_uint(pmax), __float_as_uint(pmax), false, false); pmax = fmaxf(__uint_as_float(rr[0]), __uint_as_float(rr[1])); }
    if (__builtin_expect(__all(pmax - m_reg <= THR), 1)) { mn = m_reg; alpha = 1.f; }
    else { mn = fmaxf(m_reg, pmax); alpha = __builtin_amdgcn_exp2f(m_reg - mn); m_reg = mn; }
#pragma unroll
    for (int r = 0; r < 16; ++r) { p0[r] -= mn; p1[r] -= mn; }
#pragma unroll
    for (int r = 0; r < 16; ++r) p0[r] = __builtin_amdgcn_exp2f(p0[r]);
}
__device__ __forceinline__ void finishSM(f32x16& p0, f32x16& p1, float alpha, float& l_reg, bf16x8& pa0, bf16x8& pa1, bf16x8& pa2, bf16x8& pa3) {
#pragma unroll
    for (int r = 0; r < 16; ++r) p1[r] = __builtin_amdgcn_exp2f(p1[r]);
    float ps = 0;
#pragma unroll
    for (int r = 0; r < 16; ++r) ps += p0[r];
#pragma unroll
    for (int r = 0; r < 16; ++r) ps += p1[r];
    { auto rr = __builtin_amdgcn_permlane32_swap(__float_as_uint(ps), __float_as_uint(ps), false, false); ps = __uint_as_float(rr[0]) + __uint_as_float(rr[1]); }
    l_reg = l_reg * alpha + ps;
#define PK4(P, BASE, OUT) do { unsigned a0 = pk_bf16(P[BASE + 0], P[BASE + 1]), a1 = pk_bf16(P[BASE + 2], P[BASE + 3]);   \
    unsigned b0 = pk_bf16(P[BASE + 4], P[BASE + 5]), b1 = pk_bf16(P[BASE + 6], P[BASE + 7]);                              \
    auto r0 = __builtin_amdgcn_permlane32_swap(a0, b0, false, false); auto r1 = __builtin_amdgcn_permlane32_swap(a1, b1, false, false); \
    u32x4 w = {r0[0], r1[0], r0[1], r1[1]}; OUT = __builtin_bit_cast(bf16x8, w); } while (0)
    PK4(p0, 0, pa0); PK4(p0, 8, pa1); PK4(p1, 0, pa2); PK4(p1, 8, pa3);
#undef PK4
}
__device__ __forceinline__ void qkt(f32x16& p0, f32x16& p1, const LAS unsigned char* Kn, const LAS unsigned char* Kp, const bf16x8* qr, const int* kx, const int* px, bool masked) {
    p0 = f32x16{}; p1 = f32x16{};
#pragma unroll
    for (int d0 = 0; d0 < 8; ++d0) {
        const bf16x8 b0 = *(const LAS bf16x8*)(Kn + kx[d0 & 3] + (d0 >> 2) * 128);
        const bf16x8 b1 = *(const LAS bf16x8*)(Kn + kx[d0 & 3] + (d0 >> 2) * 128 + 8192);
        p0 = __builtin_amdgcn_mfma_f32_32x32x16_bf16(b0, qr[d0], p0, 0, 0, 0);
        p1 = __builtin_amdgcn_mfma_f32_32x32x16_bf16(b1, qr[d0], p1, 0, 0, 0); }
#pragma unroll
    for (int d0 = 0; d0 < 4; ++d0) {
        const bf16x8 b0 = *(const LAS bf16x8*)(Kp + px[d0]);
        const bf16x8 b1 = *(const LAS bf16x8*)(Kp + px[d0] + 4096);
        p0 = __builtin_amdgcn_mfma_f32_32x32x16_bf16(b0, qr[8 + d0], p0, 0, 0, 0);
        p1 = __builtin_amdgcn_mfma_f32_32x32x16_bf16(b1, qr[8 + d0], p1, 0, 0, 0); }
    if (masked) {
#pragma unroll
        for (int r = 0; r < 16; ++r) { p0[r] = -INFINITY; p1[r] = -INFINITY; } }
}
__device__ __forceinline__ int v_st(int k, int c) { const int kk = (k & ~0xC) | ((k & 4) << 1) | ((k & 8) >> 1); return ((kk >> 3) * 4 + (c >> 5)) * 512 + ((kk & 7) * 32 + (c & 31)) * 2; }
__device__ __forceinline__ int v_rd_base(int lane) { return ((lane & 3) << 3) | (((lane >> 2) & 3) << 6) | (((lane >> 4) & 1) << 5) | (((lane >> 5) & 1) << 8); }
constexpr int v_rd_off(int d0, int ks, int half) { return d0 * 512 + ks * 4096 + half * 2048; }
template <int OFF> __device__ __forceinline__ s16x4 tr_read(int vb) { s16x4 r; asm volatile("ds_read_b64_tr_b16 %0, %1 offset:%2" : "=&v"(r) : "v"(vb), "i"(OFF) : "memory"); return r; }
template <int D0> __device__ __forceinline__ void pv_one(f32x16& od, int vb, bf16x8 pa0, bf16x8 pa1, bf16x8 pa2, bf16x8 pa3) {
    const s16x4 l0 = tr_read<v_rd_off(D0, 0, 0)>(vb), h0 = tr_read<v_rd_off(D0, 0, 1)>(vb), l1 = tr_read<v_rd_off(D0, 1, 0)>(vb), h1 = tr_read<v_rd_off(D0, 1, 1)>(vb);
    const s16x4 l2 = tr_read<v_rd_off(D0, 2, 0)>(vb), h2 = tr_read<v_rd_off(D0, 2, 1)>(vb), l3 = tr_read<v_rd_off(D0, 3, 0)>(vb), h3 = tr_read<v_rd_off(D0, 3, 1)>(vb);
    asm volatile("s_waitcnt lgkmcnt(0)" ::: "memory"); SBAR();
#define PK(L, H) (bf16x8){L[0], L[1], L[2], L[3], H[0], H[1], H[2], H[3]}
    od = __builtin_amdgcn_mfma_f32_32x32x16_bf16(pa0, PK(l0, h0), od, 0, 0, 0);
    od = __builtin_amdgcn_mfma_f32_32x32x16_bf16(pa1, PK(l1, h1), od, 0, 0, 0);
    od = __builtin_amdgcn_mfma_f32_32x32x16_bf16(pa2, PK(l2, h2), od, 0, 0, 0);
    od = __builtin_amdgcn_mfma_f32_32x32x16_bf16(pa3, PK(l3, h3), od, 0, 0, 0);
#undef PK
}
__device__ __forceinline__ void pv_d0(f32x16* o, int vb, bf16x8 pa0, bf16x8 pa1, bf16x8 pa2, bf16x8 pa3) {
    pv_one<0>(o[0], vb, pa0, pa1, pa2, pa3); pv_one<1>(o[1], vb, pa0, pa1, pa2, pa3); pv_one<2>(o[2], vb, pa0, pa1, pa2, pa3); pv_one<3>(o[3], vb, pa0, pa1, pa2, pa3);
}

__device__ __forceinline__ void attn_unit(int b, int h, int qb, const bf16_t* __restrict__ Q, const bf16_t* __restrict__ KN, const bf16_t* __restrict__ KP, const bf16_t* __restrict__ V, bf16_t* __restrict__ O, LAS unsigned char* lds) {
    const int tid = threadIdx.x, wid = __builtin_amdgcn_readfirstlane(tid >> 6), lane = tid & 63, r32 = lane & 31, hi = lane >> 5;
    LAS float* ws = (LAS float*)(lds + OFF_WS) + wid * 64; LAS float* li_l = ws; LAS float* al_l = ws + 32;
    const size_t rowbase = (size_t)b * SEQ; const int q0 = qb * (QBLK * NW);
    float m_reg = -1e30f, l_reg = 0; f32x16 o[4] = {}; bf16x8 qr[12];
    { const char* qbase = (const char*)(Q + (rowbase + q0 + wid * QBLK) * LDQ + h * DQK); const unsigned qoff = (unsigned)(r32 * LDQ + hi * 8) * 2u;
#pragma unroll
      for (int d0 = 0; d0 < 12; ++d0) qr[d0] = *reinterpret_cast<const bf16x8*>(qbase + qoff + d0 * 32); }
    const bf16_t* Kh = KN + rowbase * LDK + h * DN; const bf16_t* Vh = V + rowbase * LDK + h * DV; const bf16_t* Ph = KP + rowbase * LDP;
    unsigned gk0, gp0, gv0;
    { const int row = wid * 4 + (lane >> 4); gk0 = (unsigned)(row * (LDK * 2) + (((lane & 15) ^ (row & 7)) << 4)); }
    { const int row = wid * 8 + (lane >> 3); gp0 = (unsigned)(row * (LDP * 2) + (((lane & 7) ^ (row & 7)) << 4)); }
    { const int st = 2 * wid + (lane >> 5), q = lane & 31, kk = (st >> 2) * 8 + (q >> 2), c = (st & 3) * 32 + (q & 3) * 8, k = (kk & ~0xC) | ((kk & 4) << 1) | ((kk & 8) >> 1); gv0 = (unsigned)(k * (LDK * 2) + c * 2); }
    const unsigned ldsw = (unsigned)wid * 1024u;
#define GLDS(src, dst) __builtin_amdgcn_global_load_lds((const unsigned*)(src), (LAS unsigned*)(dst), 16, 0, 0)
#define DMA_K(j, bb) do { const char* kt_ = (const char*)(Kh + (size_t)(j) * KVBLK * LDK); const char* pt_ = (const char*)(Ph + (size_t)(j) * KVBLK * LDP); \
    GLDS(kt_ + gk0, lds + OFF_KN + (bb) * SHM_KN + ldsw); GLDS(kt_ + gk0 + 32 * LDK * 2, lds + OFF_KN + (bb) * SHM_KN + 8192 + ldsw); GLDS(pt_ + gp0, lds + OFF_KP + (bb) * SHM_KP + ldsw); } while (0)
#define DMA_V(j, bb) do { const char* vt_ = (const char*)(Vh + (size_t)(j) * KVBLK * LDK); \
    GLDS(vt_ + gv0, lds + OFF_V + (bb) * SHM_V + ldsw); GLDS(vt_ + gv0 + 32 * LDK * 2, lds + OFF_V + (bb) * SHM_V + 8192 + ldsw); } while (0)
#define STEP_END() do { asm volatile("s_waitcnt vmcnt(0) lgkmcnt(0)" ::: "memory"); __builtin_amdgcn_s_barrier(); asm volatile("" ::: "memory"); } while (0)
#define RESC(a) do { if (__any((a) < 1.f)) { if (hi == 0) al_l[r32] = (a); asm volatile("s_waitcnt lgkmcnt(0)" ::: "memory"); \
    _Pragma("unroll") for (int d = 0; d < 4; ++d) _Pragma("unroll") for (int r = 0; r < 16; ++r) o[d][r] *= al_l[crow(r, hi)]; } } while (0)
    int kx[4], px[4];
#pragma unroll
    for (int q = 0; q < 4; ++q) { kx[q] = r32 * 256 + (((2 * q + hi) ^ (r32 & 7)) << 4); px[q] = r32 * 128 + (((2 * q + hi) ^ (r32 & 7)) << 4); }
    const LAS unsigned char* K0 = lds + OFF_KN; const LAS unsigned char* K1 = lds + OFF_KN + SHM_KN; const LAS unsigned char* P0 = lds + OFF_KP; const LAS unsigned char* P1 = lds + OFF_KP + SHM_KP;
    const int vb0 = (int)(uintptr_t)(lds + OFF_V) + v_rd_base(lane);
    const int NT = 4 * qb + 4, jmax = 4 * qb + (wid >> 1);
    f32x16 pA0, pA1, pB0, pB1; float mnA, mnB, alA, alB; bf16x8 pa0, pa1, pa2, pa3;
    DMA_K(0, 0);
    STEP_END();
    DMA_K(1, 1); DMA_V(0, 0);
    qkt(pA0, pA1, K0, P0, qr, kx, px, false); partialSM(pA0, pA1, m_reg, mnA, alA);
    STEP_END();
    for (int j = 1; j + 1 < NT; j += 2) {
        DMA_K(j + 1, 0); DMA_V(j, 1);
        SBAR(); qkt(pB0, pB1, K1, P1, qr, kx, px, j > jmax);
        finishSM(pA0, pA1, alA, l_reg, pa0, pa1, pa2, pa3); SBAR();
        pv_d0(o, vb0, pa0, pa1, pa2, pa3); partialSM(pB0, pB1, m_reg, mnB, alB);
        RESC(alB);
        STEP_END();
        DMA_K(j + 2, 1); DMA_V(j + 1, 0);
        SBAR(); qkt(pA0, pA1, K0, P0, qr, kx, px, j + 1 > jmax);
        finishSM(pB0, pB1, alB, l_reg, pa0, pa1, pa2, pa3); SBAR();
        pv_d0(o, vb0 + SHM_V, pa0, pa1, pa2, pa3); partialSM(pA0, pA1, m_reg, mnA, alA);
        RESC(alA);
        STEP_END();
    }
    DMA_V(NT - 1, 1);
    SBAR(); qkt(pB0, pB1, K1, P1, qr, kx, px, NT - 1 > jmax);
    finishSM(pA0, pA1, alA, l_reg, pa0, pa1, pa2, pa3); SBAR();
    pv_d0(o, vb0, pa0, pa1, pa2, pa3); partialSM(pB0, pB1, m_reg, mnB, alB);
    RESC(alB);
    STEP_END();
    finishSM(pB0, pB1, alB, l_reg, pa0, pa1, pa2, pa3); SBAR();
    pv_d0(o, vb0 + SHM_V, pa0, pa1, pa2, pa3);
    if (hi == 0) li_l[r32] = l_reg;
    asm volatile("s_waitcnt lgkmcnt(0)" ::: "memory");
    float rli[16];
#pragma unroll
    for (int r = 0; r < 16; ++r) rli[r] = __builtin_amdgcn_rcpf(li_l[crow(r, hi)]);
    STEP_END();
    { LAS bf16_t* stg = (LAS bf16_t*)lds + wid * (QBLK * DV);
        int ln = lane; asm volatile("" : "+v"(ln));
        const int r32e = ln & 31, hie = ln >> 5;
#pragma unroll
        for (int r = 0; r < 16; ++r) { const int orow = crow(r, hie);
#pragma unroll
            for (int d0 = 0; d0 < 4; ++d0) stg[orow * DV + d0 * 32 + r32e] = (bf16_t)(pk_bf16(o[d0][r] * rli[r], 0.f) & 0xffffu); }
        asm volatile("s_waitcnt lgkmcnt(0)" ::: "memory");
        char* Ow = (char*)(O + (rowbase + q0 + wid * QBLK) * LDO + h * DV);
        const unsigned ooff = (unsigned)((ln >> 4) * LDO + (ln & 15) * 8) * 2u; const int soff = (ln >> 4) * DV + (ln & 15) * 8;
#pragma unroll
        for (int i = 0; i < 8; ++i) { const u32x4 v = *(const LAS u32x4*)(stg + soff + i * 4 * DV); *(u32x4*)(Ow + ooff + (unsigned)(i * 4 * LDO * 2)) = v; } }
    STEP_END();
#undef GLDS
#undef DMA_K
#undef DMA_V
#undef STEP_END
#undef RESC
}
#undef KSWZ
#undef PSWZ
#undef SBAR
}

#define XB_TMO      128
#define XB_XCNT(j)  (256  + 64 * (j))
#define XB_XSUB(j)  (1280 + 64 * (j))
#define XB_XGEN(j)  (2304 + 64 * (j))
#define XB_TOP      3328
#define XB_TOPGEN   3392
#define XCD_BAR_WORDS 3456
#define XB_SPIN_CAP (1u << 18)
__device__ __forceinline__ unsigned xb_ld(unsigned* p)              { return __hip_atomic_load(p, __ATOMIC_RELAXED, __HIP_MEMORY_SCOPE_AGENT); }
__device__ __forceinline__ unsigned xb_add(unsigned* p, unsigned v) { return __hip_atomic_fetch_add(p, v, __ATOMIC_RELAXED, __HIP_MEMORY_SCOPE_AGENT); }
__device__ __forceinline__ unsigned xb_xcc_id() { return (unsigned)__builtin_amdgcn_s_getreg((3 << 11) | 20) & 0xFu; }
#define XB_SPIN(cond, bar) do { unsigned _sp = 0; while (cond) { __builtin_amdgcn_s_sleep(1); \
    if ((++_sp & 255u) == 0u) { if (xb_ld(&(bar)[XB_TMO])) break; if (_sp > XB_SPIN_CAP) { atomicAdd(&(bar)[XB_TMO], 1u); break; } } } } while (0)
struct XcdBarrier { unsigned* bar; unsigned x; volatile LAS unsigned* st; };
__device__ __forceinline__ XcdBarrier xcd_barrier_post(unsigned* bar, volatile LAS unsigned* st) {
    XcdBarrier b; b.bar = bar; b.x = xb_xcc_id(); b.st = st;
    if (threadIdx.x == 0) (void)xb_add(&bar[XB_XCNT(b.x)], 1u);
    return b;
}
__device__ __forceinline__ void xcd_barrier_complete(unsigned* bar, unsigned x, unsigned& nloc, unsigned& nx) {
    const unsigned G = gridDim.x * gridDim.y * gridDim.z;
    unsigned sum, cnt, mine, sp = 0u;
    for (;;) {
        sum = 0u; cnt = 0u; mine = 0u;
#pragma unroll
        for (unsigned j = 0; j < 16; ++j) { const unsigned c = xb_ld(&bar[XB_XCNT(j)]); sum += c; cnt += (c > 0u) ? 1u : 0u; mine = (j == x) ? c : mine; }
        if (sum == G) break;
        __builtin_amdgcn_s_sleep(1);
        if ((++sp & 255u) == 0u) { if (xb_ld(&bar[XB_TMO])) break; if (sp > XB_SPIN_CAP) { atomicAdd(&bar[XB_TMO], 1u); break; } }
    }
    nloc = mine > 0u ? mine : 1u; nx = cnt > 0u ? cnt : 1u;
}
__device__ __forceinline__ void xcd_barrier(const XcdBarrier& b) {
    asm volatile("s_waitcnt vmcnt(0)" ::: "memory");
    __syncthreads();
    if (threadIdx.x == 0) {
        unsigned* bar = b.bar;
        __builtin_amdgcn_s_waitcnt(0);
        unsigned nloc = b.st[0], nx = b.st[1];
        if (nloc == 0u) { xcd_barrier_complete(bar, b.x, nloc, nx); b.st[0] = nloc; b.st[1] = nx; }
        const unsigned old = xb_add(&bar[XB_XSUB(b.x)], 1u);
        const unsigned gen = old / nloc;
        if (old + 1u == (gen + 1u) * nloc) {
            __builtin_amdgcn_fence(__ATOMIC_RELEASE, "agent");
            asm volatile("s_waitcnt vmcnt(0)" ::: "memory");
            const unsigned og = xb_add(&bar[XB_TOP], 1u);
            const unsigned tg = og / nx;
            if (og + 1u == (tg + 1u) * nx) xb_add(&bar[XB_TOPGEN], 1u);
            else XB_SPIN(xb_ld(&bar[XB_TOPGEN]) == tg, bar);
            __builtin_amdgcn_fence(__ATOMIC_ACQUIRE, "agent");
            xb_add(&bar[XB_XGEN(b.x)], 1u);
            asm volatile("s_waitcnt vmcnt(0)" ::: "memory");
        } else {
            XB_SPIN(xb_ld(&bar[XB_XGEN(b.x)]) == gen, bar);
            __builtin_amdgcn_fence(__ATOMIC_ACQUIRE, "agent");
            asm volatile("s_waitcnt vmcnt(0)" ::: "memory");
        }
    }
    __syncthreads();
}

__device__ __forceinline__ void tr_item(const float* __restrict__ W, int N, int k0, int n0, bf16_t* __restrict__ WT, int Kd, size_t dlo, size_t dhi, const float* __restrict__ g, LAS float* scr, int lane) {
#pragma unroll 4
    for (int i = 0; i < 16; ++i) { const int k = 4 * i + (lane >> 4), n = 4 * (lane & 15);
        f32x4 v = *(const f32x4*)(W + (size_t)(k0 + k) * N + n0 + n);
        if (g) v = v * g[k0 + k];
        LAS float* s = scr + k * 65 + n; s[0] = v[0]; s[1] = v[1]; s[2] = v[2]; s[3] = v[3]; }
    LDS_WAIT(); asm volatile("" ::: "memory");
    const int c = lane & 7;
#pragma unroll
    for (int j = 0; j < 8; ++j) { const int n = (lane >> 3) + 8 * j; const LAS float* s = scr + (8 * c) * 65 + n;
        u32x4 o; o.x = pk_bf16(s[0 * 65], s[1 * 65]); o.y = pk_bf16(s[2 * 65], s[3 * 65]); o.z = pk_bf16(s[4 * 65], s[5 * 65]); o.w = pk_bf16(s[6 * 65], s[7 * 65]);
        const size_t drow = (n < 32) ? dlo + n : dhi + (n - 32);
        *(u32x4*)(WT + drow * Kd + k0 + 8 * c) = o; }
    LDS_WAIT(); asm volatile("" ::: "memory");
}

struct Args { const void* in[22]; float* out; unsigned char* ws; int ph_lo, ph_hi; };

__global__ void __launch_bounds__(512, 2) mk_fwd(Args args) {
    extern __shared__ __attribute__((aligned(16))) unsigned char lds_raw[];
    LAS unsigned char* lds = (LAS unsigned char*)lds_raw;
    volatile LAS unsigned* MISC = (volatile LAS unsigned*)(lds + MISC_OFF);
    volatile LAS int* TST = (volatile LAS int*)(lds + MISC_OFF + 64);
    volatile LAS int* CNT = (volatile LAS int*)(lds + MISC_OFF + 256);
    const int tid = threadIdx.x, lane = tid & 63, wave = __builtin_amdgcn_readfirstlane(tid >> 6);
    const int G = gridDim.x, bx = blockIdx.x;
    const int vcu = (G % 8 == 0) ? (bx % 8) * (G / 8) + bx / 8 : bx;
    unsigned char* ws = args.ws;
    unsigned* ctl = (unsigned*)(ws + WS_CTL);
    const float* x = (const float*)args.in[0]; const int* positions = (const int*)args.in[1];
    const float* w_in = (const float*)args.in[2]; const float* conv_w = (const float*)args.in[3]; const float* q_norm_g = (const float*)args.in[4];
    const float* w_uq = (const float*)args.in[5]; const float* kv_norm_g = (const float*)args.in[6]; const float* w_uk = (const float*)args.in[7]; const float* w_uv = (const float*)args.in[8];
    const float* w_cb = (const float*)args.in[9]; const float* w_ab = (const float*)args.in[10]; const float* w_out = (const float*)args.in[11];
    const float* ln1_g = (const float*)args.in[12]; const float* ln1_b = (const float*)args.in[13]; const float* w_router = (const float*)args.in[14]; const float* b_router = (const float*)args.in[15];
    const float* w_gu = (const float*)args.in[16]; const float* b_gu = (const float*)args.in[17]; const float* w_dn = (const float*)args.in[18]; const float* b_dn = (const float*)args.in[19];
    const float* ln2_g = (const float*)args.in[20]; const float* ln2_b = (const float*)args.in[21];
    float* out = args.out;
    float* ssq_q = (float*)(ws + WS_SSQ); float* ssq_kv = ssq_q + T;
    bf16_t* XB = (bf16_t*)(ws + WS_XB); bf16_t* WinT = (bf16_t*)(ws + WS_WIN); bf16_t* WuqT = (bf16_t*)(ws + WS_WUQ); bf16_t* WkvT = (bf16_t*)(ws + WS_WKV);
    bf16_t* WcbT = (bf16_t*)(ws + WS_WCB); bf16_t* WabT = (bf16_t*)(ws + WS_WAB); bf16_t* WoutT = (bf16_t*)(ws + WS_WOUT);
    float* tab_cos = (float*)(ws + WS_TAB); float* tab_sin = tab_cos + (size_t)T * 32;
    bf16_t* KPE = (bf16_t*)(ws + WS_KPE);
    int* tope = (int*)(ws + WS_TOP); float* topw = (float*)(tope + (size_t)T * 4); int* tpos = (int*)(topw + (size_t)T * 4);
    int* list = (int*)(ws + WS_LIST);
    bf16_t* WguT = (bf16_t*)(ws + WS_WGU); bf16_t* WdT = (bf16_t*)(ws + WS_WD);
    bf16_t* PROJ = (bf16_t*)(ws + WS_PROJ); bf16_t* HID = (bf16_t*)(ws + WS_HID);
    bf16_t* Qb = (bf16_t*)(ws + WS_Q); bf16_t* KNb = (bf16_t*)(ws + WS_KN); bf16_t* Vb = (bf16_t*)(ws + WS_V); bf16_t* CI = (bf16_t*)(ws + WS_CI); bf16_t* EO = (bf16_t*)(ws + WS_EO);
    bf16_t* YC = (bf16_t*)(ws + WS_YC); bf16_t* AO = (bf16_t*)(ws + WS_AO); bf16_t* MG = (bf16_t*)(ws + WS_MG);
    float* H1 = (float*)(ws + WS_H1); float* X1F = (float*)(ws + WS_X1F); bf16_t* X1B = (bf16_t*)(ws + WS_X1B);
    unsigned* ecnt = ctl + CW_CNT;

    for (int u = tid; u < 256; u += 512) ((LAS unsigned*)(lds + MISC_OFF))[u] = 0u;
    __syncthreads();
    XcdBarrier bar; bar.bar = ctl + CW_BAR; bar.x = 0; bar.st = nullptr;
    if (N_LAUNCHES == 1) bar = xcd_barrier_post(ctl + CW_BAR, MISC);
    const int lo = args.ph_lo, hi = args.ph_hi;
#ifndef MK_PHASE_MASK
#define MK_PHASE_MASK 0x3ff
#endif
#define IN(k) ((((MK_PHASE_MASK) >> (k)) & 1) && lo <= (k) && (k) < hi)
#define GRID_BAR(k) do { if (IN(k) && IN((k) + 1)) xcd_barrier(bar); } while (0)
    const int gw = vcu * 8 + wave, NGW = G * 8;
    const int gt = vcu * 512 + tid, NGT = G * 512;

    if (IN(0)) {
        LAS float* scr = (LAS float*)(lds + wave * 16896);
        constexpr int I_IN = 16 * 91, I_UQ = 6 * 24, I_UK = 4 * 16, I_UV = 4 * 16, I_SQ = 16 * 16, I_GU = NE * 16 * 32, I_DN = NE * 16 * 16;
        constexpr int NITEMS = I_IN + I_UQ + I_UK + I_UV + 3 * I_SQ + I_GU + I_DN;
        for (int it = gw; it < NITEMS; it += NGW) {
            int r = it;
            if (r < I_GU) { const int e = r / 512, rr = r % 512, kb = rr / 32, nb = rr % 32; const int n0 = 64 * nb;
                const size_t d = (n0 < DFF) ? (size_t)(256 * (n0 / 128) + (n0 % 128)) : (size_t)(256 * ((n0 - DFF) / 128) + 128 + (n0 - DFF) % 128);
                tr_item(w_gu + (size_t)e * DM * 2 * DFF, 2 * DFF, 64 * kb, n0, WguT + (size_t)e * 2 * DFF * DM, DM, d, d + 32, nullptr, scr, lane); continue; } r -= I_GU;
            if (r < I_DN) { const int e = r / 256, rr = r % 256, kb = rr / 16, nb = rr % 16;
                tr_item(w_dn + (size_t)e * DFF * DM, DM, 64 * kb, 64 * nb, WdT + (size_t)e * DM * DFF, DFF, 64 * nb, 64 * nb + 32, nullptr, scr, lane); continue; } r -= I_DN;
            if (r < I_IN) { const int kb = r / 91, nb = r % 91; tr_item(w_in, IN_DIM, 64 * kb, 64 * nb, WinT, DM, 64 * nb, 64 * nb + 32, nullptr, scr, lane); continue; } r -= I_IN;
            if (r < I_UQ) { const int kb = r / 24, nb = r % 24; const int n0 = 64 * nb, head = n0 / DQK, within = n0 % DQK;
                size_t dl, dh;
                if (within < DN) { dl = (size_t)(256 * (head / 2) + 128 * (head % 2) + within); dh = dl + 32; }
                else { dl = (size_t)(256 * (4 + head / 4) + 32 * (head % 4)); dh = dl + 128; }
                tr_item(w_uq, NH * DQK, 64 * kb, n0, WuqT, QL, dl, dh, q_norm_g, scr, lane); continue; } r -= I_UQ;
            if (r < I_UK) { const int kb = r / 16, nb = r % 16; tr_item(w_uk, NH * DN, 64 * kb, 64 * nb, WkvT, KVL, 64 * nb, 64 * nb + 32, kv_norm_g, scr, lane); continue; } r -= I_UK;
            if (r < I_UV) { const int kb = r / 16, nb = r % 16; tr_item(w_uv, NH * DV, 64 * kb, 64 * nb, WkvT, KVL, 1024 + 64 * nb, 1024 + 64 * nb + 32, kv_norm_g, scr, lane); continue; } r -= I_UV;
            { const int w = r / I_SQ, rr = r % I_SQ, kb = rr / 16, nb = rr % 16; const float* src = (w == 0) ? w_cb : (w == 1) ? w_ab : w_out; bf16_t* dst = (w == 0) ? WcbT : (w == 1) ? WabT : WoutT;
                tr_item(src, DM, 64 * kb, 64 * nb, dst, DM, 64 * nb, 64 * nb + 32, nullptr, scr, lane); }
        }
        for (int i = gt; i < (NPROJ - IN_DIM) * DM / 8; i += NGT) *(u32x4*)(WinT + (size_t)IN_DIM * DM + (size_t)i * 8) = (u32x4){0u, 0u, 0u, 0u};
        for (int i = gt; i < T * DM / 8; i += NGT) { const f32x4 a = *(const f32x4*)(x + (size_t)i * 8), b = *(const f32x4*)(x + (size_t)i * 8 + 4); *(u32x4*)(XB + (size_t)i * 8) = pg8::pack8(a, b); }
        for (int i = gt; i < T * 32; i += NGT) { const int t = i >> 5, f = i & 31; const float invf = powf(10000.0f, -(float)f / 32.0f); const float ang = (float)positions[t] * invf;
            float s, c; sincosf(ang, &s, &c); tab_cos[i] = c; tab_sin[i] = s; }
    }
    GRID_BAR(0);

    if (IN(1)) {
        pg8::Gemm g{XB, WinT, DM, DM}; pg8::StaticOrder S; S.init(T, NPROJ, G, bx);
        pg8::EpiProj E{PROJ, ssq_q, ssq_kv};
        pg8::gemm_phase<pg8::EpiProj, pg8::StaticOrder, true>(lds, g, S, E);
    }
    GRID_BAR(1);

    if (IN(2)) {
#ifndef DBG_P2
#define DBG_P2 15
#endif
        if (DBG_P2 & 1) { const int cg = (tid & 127) * 8, rs = tid >> 7;
          f32x4 w0a = *(const f32x4*)(conv_w + cg), w0b = *(const f32x4*)(conv_w + cg + 4), w1a = *(const f32x4*)(conv_w + DM + cg), w1b = *(const f32x4*)(conv_w + DM + cg + 4),
                w2a = *(const f32x4*)(conv_w + 2 * DM + cg), w2b = *(const f32x4*)(conv_w + 2 * DM + cg + 4);
          for (int it = vcu; it < T / 16; it += G) { const int t0 = it * 16 + rs * 4;
              f32x4 um2a = {0, 0, 0, 0}, um2b = um2a, um1a = um2a, um1b = um2a;
#pragma unroll
              for (int d = -2; d < 4; ++d) { const int t = t0 + d; f32x4 ua = {0, 0, 0, 0}, ub = ua;
                  if (d >= 0 || (t0 & (SEQ - 1)) + d >= 0) { const bf16_t* pr = PROJ + (size_t)t * NPROJ + cg;
                      f32x4 ga, gb_, ha, hb; pg8::unpack8(*(const u32x4*)(pr + OFF_GC), ga, gb_); pg8::unpack8(*(const u32x4*)(pr + OFF_HC), ha, hb); ua = ga * ha; ub = gb_ * hb; }
                  if (d >= 0) { const bf16_t* pr = PROJ + (size_t)t * NPROJ + cg; f32x4 ba, bb; pg8::unpack8(*(const u32x4*)(pr + OFF_GB), ba, bb);
                      const f32x4 ca = ba * (w0a * um2a + w1a * um1a + w2a * ua), cb = bb * (w0b * um2b + w1b * um1b + w2b * ub);
                      *(u32x4*)(CI + (size_t)t * DM + cg) = pg8::pack8(ca, cb); }
                  um2a = um1a; um2b = um1b; um1a = ua; um1b = ub; } } }
        if (DBG_P2 & 2) for (int i = gt; i < T * 32; i += NGT) { const int t = i >> 5, f = i & 31; const bf16_t* kp = PROJ + (size_t)t * NPROJ + OFF_KPE;
            const float k1 = __uint_as_float((unsigned)kp[f] << 16), k2 = __uint_as_float((unsigned)kp[f + 32] << 16), c = tab_cos[i], s = tab_sin[i];
            KPE[(size_t)t * DR + f] = (bf16_t)(pk_bf16(k1 * c - k2 * s, 0.f) & 0xffffu); KPE[(size_t)t * DR + f + 32] = (bf16_t)(pk_bf16(k1 * s + k2 * c, 0.f) & 0xffffu); }
        if (DBG_P2 & 4) { pg8::Gemm g{PROJ + OFF_QL, WuqT, NPROJ, QL}; pg8::StaticOrder S; S.init(T, NH * DQK, G, bx);
          pg8::EpiQ E{Qb, ssq_q, tab_cos, tab_sin};
          pg8::gemm_phase<pg8::EpiQ, pg8::StaticOrder, true>(lds, g, S, E); }
        if (DBG_P2 & 8) { pg8::Gemm g{PROJ + OFF_KVL, WkvT, NPROJ, KVL}; pg8::StaticOrder S; S.init(T, 2 * NH * DN, G, bx);
          pg8::EpiKV E{KNb, Vb, ssq_kv};
          pg8::gemm_phase<pg8::EpiKV, pg8::StaticOrder, true>(lds, g, S, E); }
    }
    GRID_BAR(2);

    if (IN(3)) {
#ifndef DBG_NO_YC
        { pg8::Gemm g{CI, WcbT, DM, DM}; pg8::StaticOrder S; S.init(T, DM, G, bx);
          pg8::EpiGate<false> E{YC, PROJ, OFF_GCONV, nullptr};
          pg8::gemm_phase<pg8::EpiGate<false>, pg8::StaticOrder, true>(lds, g, S, E); }
#endif
#ifndef DBG_NO_ATT
        for (int p = vcu; p < BATCH * NH * 8; p += G) { const int bh = p >> 3, s = p & 7;
            _Pragma("nounroll") for (int ui = 0; ui < 2; ++ui) att::attn_unit(bh / NH, bh % NH, ui ? s : 15 - s, Qb, KNb, KPE, Vb, AO, lds); }
#endif
    }
    GRID_BAR(3);

    if (IN(4)) {
        pg8::Gemm g{AO, WabT, DM, DM}; pg8::StaticOrder S; S.init(T, DM, G, bx);
        pg8::EpiGate<true> E{MG, PROJ, OFF_GATTN, YC};
        pg8::gemm_phase<pg8::EpiGate<true>, pg8::StaticOrder, true>(lds, g, S, E);
    }
    GRID_BAR(4);

    if (IN(5)) {
        pg8::Gemm g{MG, WoutT, DM, DM}; pg8::StaticOrder S; S.init(T, DM, G, bx);
        pg8::EpiH1 E{H1, x};
        pg8::gemm_phase<pg8::EpiH1, pg8::StaticOrder, true>(lds, g, S, E);
    }
    GRID_BAR(5);

    if (IN(6)) {
        LAS float* Wt = (LAS float*)lds;
        for (int i = tid; i < DM * NE / 4; i += 512) { const int k = i >> 3, q4 = (i & 7) * 4; const f32x4 v = *(const f32x4*)(w_router + (size_t)k * NE + q4);
            Wt[(q4 + 0) * DM + k] = v[0]; Wt[(q4 + 1) * DM + k] = v[1]; Wt[(q4 + 2) * DM + k] = v[2]; Wt[(q4 + 3) * DM + k] = v[3]; }
        LAS unsigned* lhist = (LAS unsigned*)(lds + MISC_OFF + 512); LAS unsigned* lbase = lhist + 32; LAS int* recs = (LAS int*)(lds + MISC_OFF + 768);
        if (tid < 64) lhist[tid] = 0u;
        if (tid < 256) recs[2 * tid] = -1;
        __syncthreads();
        f32x4 gv[4], bv[4];
#pragma unroll
        for (int j = 0; j < 4; ++j) { gv[j] = *(const f32x4*)(ln1_g + 4 * lane + 256 * j); bv[j] = *(const f32x4*)(ln1_b + 4 * lane + 256 * j); }
        const float my_bias = b_router[lane & 31];
        const bool uph = lane >= 32;
        const bool agg = (T / 2 + NGW - 1) / NGW <= 4;
        f32x4 n0[4], n1[4];
        int pr = gw;
        if (pr < T / 2) {
#pragma unroll
            for (int j = 0; j < 4; ++j) { n0[j] = *(const f32x4*)(H1 + (size_t)(2 * pr) * DM + 4 * lane + 256 * j); n1[j] = *(const f32x4*)(H1 + (size_t)(2 * pr + 1) * DM + 4 * lane + 256 * j); } }
        for (int it = 0; pr < T / 2; pr += NGW, ++it) {
            asm volatile("" ::: "memory");
            f32x4 v0[4], v1[4];
#pragma unroll
            for (int j = 0; j < 4; ++j) { v0[j] = n0[j]; v1[j] = n1[j]; }
            { const int pn = pr + NGW;
              if (pn < T / 2) {
#pragma unroll
                for (int j = 0; j < 4; ++j) { n0[j] = *(const f32x4*)(H1 + (size_t)(2 * pn) * DM + 4 * lane + 256 * j); n1[j] = *(const f32x4*)(H1 + (size_t)(2 * pn + 1) * DM + 4 * lane + 256 * j); } } }
            float s0 = 0.f, s1 = 0.f;
#pragma unroll
            for (int j = 0; j < 4; ++j) { s0 += (v0[j][0] + v0[j][1]) + (v0[j][2] + v0[j][3]); s1 += (v1[j][0] + v1[j][1]) + (v1[j][2] + v1[j][3]); }
            float a = (uph ? s1 : s0) + __shfl_xor(uph ? s0 : s1, 32);
#pragma unroll
            for (int o = 16; o >= 1; o >>= 1) a += __shfl_xor(a, o);
            float ot = __shfl_xor(a, 32);
            const float mean0 = (uph ? ot : a) * (1.f / DM), mean1 = (uph ? a : ot) * (1.f / DM);
            s0 = 0.f; s1 = 0.f;
#pragma unroll
            for (int j = 0; j < 4; ++j) { v0[j] = v0[j] - mean0; v1[j] = v1[j] - mean1;
                s0 += (v0[j][0] * v0[j][0] + v0[j][1] * v0[j][1]) + (v0[j][2] * v0[j][2] + v0[j][3] * v0[j][3]);
                s1 += (v1[j][0] * v1[j][0] + v1[j][1] * v1[j][1]) + (v1[j][2] * v1[j][2] + v1[j][3] * v1[j][3]); }
            a = (uph ? s1 : s0) + __shfl_xor(uph ? s0 : s1, 32);
#pragma unroll
            for (int o = 16; o >= 1; o >>= 1) a += __shfl_xor(a, o);
            ot = __shfl_xor(a, 32);
            const float rstd0 = 1.f / sqrtf((uph ? ot : a) * (1.f / DM) + LN_EPS), rstd1 = 1.f / sqrtf((uph ? a : ot) * (1.f / DM) + LN_EPS);
            const size_t t0 = (size_t)(2 * pr);
#pragma unroll
            for (int j = 0; j < 4; ++j) { v0[j] = v0[j] * rstd0 * gv[j] + bv[j]; v1[j] = v1[j] * rstd1 * gv[j] + bv[j];
                *(f32x4*)(X1F + t0 * DM + 4 * lane + 256 * j) = v0[j]; *(f32x4*)(X1F + (t0 + 1) * DM + 4 * lane + 256 * j) = v1[j];
                u32x2 w; w.x = pk_bf16(v0[j][0], v0[j][1]); w.y = pk_bf16(v0[j][2], v0[j][3]); *(u32x2*)(X1B + t0 * DM + 4 * lane + 256 * j) = w;
                w.x = pk_bf16(v1[j][0], v1[j][1]); w.y = pk_bf16(v1[j][2], v1[j][3]); *(u32x2*)(X1B + (t0 + 1) * DM + 4 * lane + 256 * j) = w; }
            f32x2 vv[4][4];
#pragma unroll
            for (int j = 0; j < 4; ++j)
#pragma unroll
                for (int i = 0; i < 4; ++i) vv[j][i] = (f32x2){v0[j][i], v1[j][i]};
            f32x2 p[32];
#pragma unroll
            for (int e = 0; e < 32; ++e) { f32x2 acc = {0.f, 0.f};
#pragma unroll
                for (int j = 0; j < 4; ++j) { const f32x4 w = *(const LAS f32x4*)(Wt + e * DM + 4 * lane + 256 * j);
#pragma unroll
                    for (int i = 0; i < 4; ++i) acc = __builtin_elementwise_fma(vv[j][i], (f32x2){w[i], w[i]}, acc); }
                p[e] = acc; }
            float q[32];
#pragma unroll
            for (int e = 0; e < 32; ++e) q[e] = (uph ? p[e].y : p[e].x) + __shfl_xor(uph ? p[e].x : p[e].y, 32);
#define TRSTEP(W) do { const bool up = (lane & (W)) != 0; _Pragma("unroll") for (int i = 0; i < (W); ++i) { const float mine = up ? q[i + (W)] : q[i], send = up ? q[i] : q[i + (W)]; q[i] = mine + __shfl_xor(send, (W)); } } while (0)
            TRSTEP(16); TRSTEP(8); TRSTEP(4); TRSTEP(2); TRSTEP(1);
#undef TRSTEP
            float lg = q[0] + my_bias;
            int sel[4]; float sv[4];
#pragma unroll
            for (int k = 0; k < 4; ++k) { float m = lg;
                m = fmaxf(m, __builtin_bit_cast(float, __builtin_amdgcn_mov_dpp(__builtin_bit_cast(int, m), 0xB1, 0xf, 0xf, false)));
                m = fmaxf(m, __builtin_bit_cast(float, __builtin_amdgcn_mov_dpp(__builtin_bit_cast(int, m), 0x4E, 0xf, 0xf, false)));
                m = fmaxf(m, __builtin_bit_cast(float, __builtin_amdgcn_mov_dpp(__builtin_bit_cast(int, m), 0x141, 0xf, 0xf, false)));
                m = fmaxf(m, __builtin_bit_cast(float, __builtin_amdgcn_mov_dpp(__builtin_bit_cast(int, m), 0x140, 0xf, 0xf, false)));
                m = fmaxf(m, __shfl_xor(m, 16));
                const unsigned long long bl = __ballot(lg == m); const unsigned hb = uph ? (unsigned)(bl >> 32) : (unsigned)bl;
                const int es = __builtin_ctz(hb | 0x80000000u);
                sel[k] = es; sv[k] = m; lg = ((lane & 31) == es) ? -INFINITY : lg; }
            const float e1 = __expf(sv[1] - sv[0]), e2 = __expf(sv[2] - sv[0]), e3 = __expf(sv[3] - sv[0]); const float inv = 1.f / (1.f + e1 + e2 + e3);
            const int kk = lane & 31;
            if (kk < 4) { const int e = (kk == 0) ? sel[0] : (kk == 1) ? sel[1] : (kk == 2) ? sel[2] : sel[3];
                const float w = ((kk == 0) ? 1.f : (kk == 1) ? e1 : (kk == 2) ? e2 : e3) * inv;
                const size_t t = t0 + (lane >> 5);
                tope[t * 4 + kk] = e; topw[t * 4 + kk] = w;
                if (agg) {
                    const int lpos = (int)__hip_atomic_fetch_add(lhist + e, 1u, __ATOMIC_RELAXED, __HIP_MEMORY_SCOPE_WORKGROUP);
                    const int ri = wave * 32 + it * 8 + (lane >> 5) * 4 + kk; recs[2 * ri] = (int)(t * 4 + kk); recs[2 * ri + 1] = e | (lpos << 8);
                } else {
                    const int pos = (int)__hip_atomic_fetch_add(ecnt + 64 * e, 1u, RLX_AGENT);
                    tpos[t * 4 + kk] = pos; list[(size_t)e * LIST_CAP + pos] = (int)t; } }
        }
        __syncthreads();
        if (agg) {
            if (tid < NE) { const unsigned c = lhist[tid]; lbase[tid] = c ? __hip_atomic_fetch_add(ecnt + 64 * tid, c, RLX_AGENT) : 0u; }
            __syncthreads();
            if (tid < 256) { const int tk = recs[2 * tid];
                if (tk >= 0) { const int el = recs[2 * tid + 1], e = el & 255, pos = (int)lbase[e] + (el >> 8); tpos[tk] = pos; list[(size_t)e * LIST_CAP + pos] = tk >> 2; } }
            __syncthreads();
        }
    }
    GRID_BAR(6);

    if (IN(7) || IN(8) || IN(9)) {
        if (tid < NE) CNT[tid] = (int)__hip_atomic_load(ecnt + 64 * tid, RLX_AGENT);
        __syncthreads();
        if (tid == 0) { int acc = 0; for (int e = 0; e < NE; ++e) { TST[e] = acc; acc += (CNT[e] + 255) >> 8; } TST[NE] = acc; }
        __syncthreads();
    }
    const int nMt = (IN(7) || IN(8) || IN(9)) ? TST[NE] : 0;

    if (IN(7)) {
        pg8::Gemm g{X1B, WguT, DM, DM};
        pg8::MoeOrder<true> S; S.nM = nMt; S.nN = 2 * DFF / 256; S.nwg = S.nM * S.nN; S.G = G; S.c = bx; S.tstart = TST; S.cnt = CNT; S.list = list;
        pg8::EpiGU E{HID, b_gu};
        pg8::gemm_phase<pg8::EpiGU, pg8::MoeOrder<true>, true>(lds, g, S, E);
    }
    GRID_BAR(7);

    if (IN(8)) {
        pg8::Gemm g{HID, WdT, DFF, DFF};
        pg8::MoeOrder<false> S; S.nM = nMt; S.nN = DM / 256; S.nwg = S.nM * S.nN; S.G = G; S.c = bx; S.tstart = TST; S.cnt = CNT; S.list = list;
        pg8::EpiDown E{EO, b_dn};
        pg8::gemm_phase<pg8::EpiDown, pg8::MoeOrder<false>, true>(lds, g, S, E);
    }
    GRID_BAR(8);

    if (IN(9)) {
        f32x4 gv[4], bv[4];
#pragma unroll
        for (int j = 0; j < 4; ++j) { gv[j] = *(const f32x4*)(ln2_g + 4 * lane + 256 * j); bv[j] = *(const f32x4*)(ln2_b + 4 * lane + 256 * j); }
        for (int t = gw; t < T; t += NGW) {
            int myrow = 0; float myw = 0.f;
            if (lane < 4) { const int e = tope[(size_t)t * 4 + lane]; myrow = TST[e] * 256 + tpos[(size_t)t * 4 + lane]; myw = topw[(size_t)t * 4 + lane]; }
            f32x4 v[4];
#pragma unroll
            for (int j = 0; j < 4; ++j) v[j] = *(const f32x4*)(X1F + (size_t)t * DM + 4 * lane + 256 * j) * DN_ALPHA;
#pragma unroll
            for (int k = 0; k < 4; ++k) { const int row = __builtin_amdgcn_readlane(myrow, k); const float w = __builtin_bit_cast(float, __builtin_amdgcn_readlane(__builtin_bit_cast(int, myw), k));
#pragma unroll
                for (int j = 0; j < 4; ++j) { const u32x2 q = *(const u32x2*)(EO + (size_t)row * DM + 4 * lane + 256 * j);
                    v[j][0] += w * bf_lo(q.x); v[j][1] += w * bf_hi(q.x); v[j][2] += w * bf_lo(q.y); v[j][3] += w * bf_hi(q.y); } }
            float s = 0.f;
#pragma unroll
            for (int j = 0; j < 4; ++j) s += (v[j][0] + v[j][1]) + (v[j][2] + v[j][3]);
            const float mean = wave_sum(s) * (1.f / DM); float s2 = 0.f;
#pragma unroll
            for (int j = 0; j < 4; ++j) { v[j] = v[j] - mean; s2 += (v[j][0] * v[j][0] + v[j][1] * v[j][1]) + (v[j][2] * v[j][2] + v[j][3] * v[j][3]); }
            const float rstd = 1.f / sqrtf(wave_sum(s2) * (1.f / DM) + LN_EPS);
#pragma unroll
            for (int j = 0; j < 4; ++j) *(f32x4*)(out + (size_t)t * DM + 4 * lane + 256 * j) = v[j] * rstd * gv[j] + bv[j];
        }
    }
#undef IN
#undef GRID_BAR
}

extern "C" void kernel_launch(void* const* d_in, const int* in_sizes, int n_in, void* d_out, int out_size, void* d_ws, size_t ws_size, hipStream_t stream) {
    static int grid = 0;
    if (grid == 0) {
        if (n_in != 22 || in_sizes[0] != T * DM || out_size != T * DM || ws_size < WS_END) {
            fprintf(stderr, "kernel_launch: shape mismatch: n_in %d in0 %d out %d ws %zu (need %zu)\n", n_in, n_in > 0 ? in_sizes[0] : -1, out_size, ws_size, (size_t)WS_END); grid = -1; return; }
        int dev = 0, cus = 0, per_cu = 0;
        if (hipGetDevice(&dev) != hipSuccess || hipDeviceGetAttribute(&cus, hipDeviceAttributeMultiprocessorCount, dev) != hipSuccess) { fprintf(stderr, "kernel_launch: device query failed\n"); grid = -1; return; }
        if (hipFuncSetAttribute((const void*)mk_fwd, hipFuncAttributeMaxDynamicSharedMemorySize, LDS_BYTES) != hipSuccess) { fprintf(stderr, "kernel_launch: hipFuncSetAttribute failed\n"); grid = -1; return; }
        if (hipOccupancyMaxActiveBlocksPerMultiprocessor(&per_cu, (const void*)mk_fwd, 512, LDS_BYTES) != hipSuccess || per_cu < 1) {
            fprintf(stderr, "kernel_launch: occupancy query reports %d blocks per CU\n", per_cu); (void)hipGetLastError(); grid = -1; return; }
        (void)hipGetLastError();
        grid = cus;
    }
    if (grid < 0) return;
    if (hipMemsetAsync((char*)d_ws + WS_CTL, 0, CTL_ZERO_BYTES, stream) != hipSuccess) { fprintf(stderr, "kernel_launch: memset failed\n"); return; }
    Args a{};
    for (int i = 0; i < 22; ++i) a.in[i] = d_in[i];
    a.out = (float*)d_out; a.ws = (unsigned char*)d_ws;
    for (int li = 0; li < N_LAUNCHES; ++li) {
        a.ph_lo = (N_LAUNCHES == 1) ? 0 : li; a.ph_hi = (N_LAUNCHES == 1) ? N_PHASES : li + 1;
        hipLaunchKernelGGL(mk_fwd, dim3(grid), dim3(512), LDS_BYTES, stream, a);
        const hipError_t le = hipPeekAtLastError();
        if (le != hipSuccess) { fprintf(stderr, "kernel_launch: launch %d failed: %s\n", li, hipGetErrorName(le)); break; }
    }
#ifndef MK_PROBE_PHASE
#define MK_PROBE_PHASE (-1)
#endif
    if (MK_PROBE_PHASE >= 0) {
        a.ph_lo = MK_PROBE_PHASE; a.ph_hi = MK_PROBE_PHASE + 1;
        hipLaunchKernelGGL(mk_fwd, dim3(grid), dim3(512), LDS_BYTES, stream, a);
    }
}
```

```cpp
#include <hip/hip_runtime.h>
#include <cstdio>
#include <cstdint>

#define GAS __attribute__((address_space(1)))
#define LAS __attribute__((address_space(3)))
typedef unsigned short bf16_t;
typedef short bf16x8 __attribute__((ext_vector_type(8)));
typedef short s16x4 __attribute__((ext_vector_type(4)));
typedef float f32x4 __attribute__((ext_vector_type(4)));
typedef float f32x2 __attribute__((ext_vector_type(2)));
typedef float f32x16 __attribute__((ext_vector_type(16)));
typedef unsigned u32x4 __attribute__((ext_vector_type(4)));
typedef unsigned u32x2 __attribute__((ext_vector_type(2)));

#ifndef MK_PROBE_PHASE
#define MK_PROBE_PHASE (-1)
#endif
#ifndef MK_N_LAUNCHES
#define MK_N_LAUNCHES 1
#endif
constexpr int N_PHASES = 10;
constexpr int N_LAUNCHES = MK_N_LAUNCHES;
static_assert(N_LAUNCHES == 1 || N_LAUNCHES == N_PHASES, "MK_N_LAUNCHES is 1 or 10");

constexpr int BATCH = 4, SEQ = 4096, DM = 1024, T = BATCH * SEQ;
constexpr int NH = 8, DN = 128, DR = 64, DQK = 192, DV = 128, QL = 384, KVL = 256;
constexpr int NE = 32, DFF = 1024;
constexpr int IN_DIM = 5824, NPROJ = 5888;
constexpr int OFF_GB = 0, OFF_GC = 1024, OFF_HC = 2048, OFF_QL = 3072, OFF_KVL = 3456, OFF_KPE = 3712, OFF_GCONV = 3776, OFF_GATTN = 4800;
constexpr float LN_EPS = 1e-5f, RMS_EPS = 1e-6f, DN_ALPHA = 1.1892071150027210667f, SWI_LIMIT = 7.0f, SWI_ALPHA = 1.702f;
constexpr float LOG2E = 1.4426950408889634f;
constexpr float QSCALE = 0.07216878364870323f * LOG2E;
constexpr int LIST_CAP = T;
constexpr int MAX_MT = T * 4 / 256 + NE;

constexpr size_t MiB = 1u << 20;
constexpr size_t WS_CTL = 0, CTL_ZERO_BYTES = 1 * MiB;
constexpr size_t WS_SSQ = 256 * 1024;
constexpr size_t WS_XB = 1 * MiB;
constexpr size_t WS_WIN = 33 * MiB;
constexpr size_t WS_WUQ = 45 * MiB;
constexpr size_t WS_WKV = 47 * MiB;
constexpr size_t WS_WCB = 48 * MiB, WS_WAB = 50 * MiB, WS_WOUT = 52 * MiB;
constexpr size_t WS_TAB = 54 * MiB;
constexpr size_t WS_KPE = 58 * MiB;
constexpr size_t WS_TOP = 60 * MiB;
constexpr size_t WS_LIST = 61 * MiB;
constexpr size_t WS_WGU = 64 * MiB;
constexpr size_t WS_WD = 192 * MiB;
constexpr size_t WS_PROJ = 256 * MiB;
constexpr size_t WS_HID = WS_PROJ;
constexpr size_t WS_Q = 440 * MiB;
constexpr size_t WS_KN = 488 * MiB, WS_V = 520 * MiB, WS_CI = 552 * MiB;
constexpr size_t WS_EO = WS_Q;
constexpr size_t WS_YC = 584 * MiB, WS_AO = 616 * MiB, WS_MG = 648 * MiB;
constexpr size_t WS_H1 = 680 * MiB;
constexpr size_t WS_X1F = 744 * MiB;
constexpr size_t WS_X1B = 808 * MiB;
constexpr size_t WS_END = 840 * MiB;
static_assert(WS_HID + (size_t)MAX_MT * 256 * DFF * 2 <= WS_Q && WS_EO + (size_t)MAX_MT * 256 * DM * 2 <= WS_YC, "overlay map");
constexpr int CW_TMO = 0;
constexpr int CW_BAR = 4096;
constexpr int CW_CNT = 8192;

constexpr int RING_BYTES = 131072;
constexpr int MISC_OFF = 139264;
constexpr int LDS_BYTES = 147456;

#define LDS_WAIT() asm volatile("s_waitcnt lgkmcnt(0)" ::: "memory")
#define VM_WAIT() asm volatile("s_waitcnt vmcnt(0)" ::: "memory")
#define RLX_AGENT __ATOMIC_RELAXED, __HIP_MEMORY_SCOPE_AGENT

__device__ __forceinline__ unsigned pk_bf16(float lo, float hi) {
    typedef __bf16 b2 __attribute__((ext_vector_type(2)));
    f32x2 v = {lo, hi}; b2 b = __builtin_convertvector(v, b2); return __builtin_bit_cast(unsigned, b);
}
__device__ __forceinline__ float bf_lo(unsigned w) { return __uint_as_float(w << 16); }
__device__ __forceinline__ float bf_hi(unsigned w) { return __uint_as_float(w & 0xffff0000u); }
__device__ __forceinline__ float sigmoidf_(float x) { return __builtin_amdgcn_rcpf(1.0f + __builtin_amdgcn_exp2f(-x * LOG2E)); }
__device__ __forceinline__ float wave_sum(float v) {
#pragma unroll
    for (int o = 1; o < 64; o <<= 1) v += __shfl_xor(v, o);
    return v;
}

namespace pg8 {
constexpr int BM = 256, BK = 64, HALF = 128, HTB = HALF * BK * 2, STAGE_BYTES = 8 * HTB, NXCD = 8, WGM = 8;
__device__ __forceinline__ int lds_byte(int r, int c) { const int st = (r >> 4) * 2 + (c >> 5), rr = r & 15, cc = c & 31, ob = rr * 64 + cc * 2; return st * 1024 + (ob ^ (((ob >> 9) & 1) << 5)); }
__device__ __forceinline__ void stage_rc(int b, int& R, int& C) { const int st = b / 1024, sb = b % 1024, swz = sb ^ (((sb >> 9) & 1) << 5); R = (st >> 1) * 16 + swz / 64; C = (st & 1) * 32 + (swz % 64) / 2; }
__device__ __forceinline__ int perm32(int rho) { const int n = rho >> 4, i = rho & 15; return 8 * (i >> 2) + 4 * n + (i & 3); }

struct Unit { int pm, pn, pb, e, row0, cnt; };
struct Gemm { const bf16_t* A; const bf16_t* Bt; int lda; int K; };

__device__ __forceinline__ void tile_of(int L, int nM, int nN, int& pm, int& pn) {
    const int nwg = nM * nN; int wgid = L;
    { const int q = nwg / NXCD, r = nwg % NXCD, xcd = wgid % NXCD, off = wgid / NXCD; wgid = (xcd < r ? xcd * (q + 1) : r * (q + 1) + (xcd - r) * q) + off; }
    const int nig = WGM * nN, gid = wgid / nig, fm = gid * WGM, gsz = (nM - fm) < WGM ? (nM - fm) : WGM;
    pm = fm + ((wgid % nig) % gsz); pn = (wgid % nig) / gsz;
}
struct StaticOrder {
    int nM, nN, nwg, G, c;
    __device__ void init(int M, int N, int G_, int c_) { nM = M / BM; nN = N / BM; nwg = nM * nN; G = G_; c = c_; }
    __device__ __forceinline__ bool next(int i, Unit& u) const {
        const long L = (long)i * G + c; if (L >= nwg) return false;
        tile_of((int)L, nM, nN, u.pm, u.pn); u.pb = u.pn; u.e = 0; u.row0 = 0; u.cnt = 0; return true;
    }
    __device__ __forceinline__ int arow(const Unit& u, int r) const { return u.pm * BM + r; }
    static constexpr bool PREFETCH = false;
    __device__ __forceinline__ void issue_prefetch(const Unit&, int) const {}
    __device__ __forceinline__ int arow_pf(const Unit& u, int r) const { return u.pm * BM + r; }
};
struct PairOrder {
    int nM, nN, nwg, G, c, arow_off1, pb_off1;
    __device__ __forceinline__ bool next(int i, Unit& u) const {
        const int L = (i >> 1) * G + c; if (L >= nwg) return false;
        tile_of(L, nM, nN, u.pm, u.pn); u.e = i & 1; u.pb = u.pn + (u.e ? pb_off1 : 0); u.row0 = u.e ? arow_off1 : 0; u.cnt = 0; return true;
    }
    __device__ __forceinline__ int arow(const Unit& u, int r) const { return u.pm * BM + r + u.row0; }
    static constexpr bool PREFETCH = false;
    __device__ __forceinline__ void issue_prefetch(const Unit&, int) const {}
    __device__ __forceinline__ int arow_pf(const Unit& u, int r) const { return u.pm * BM + r + u.row0; }
};
template <bool GATHER> struct MoeOrder {
    int nM, nN, nwg, G, c; const volatile LAS int* tstart; const volatile LAS int* cnt; const int* list;
    __device__ __forceinline__ bool next(int i, Unit& u) const {
        const int L = i * G + c; if (L >= nwg) return false;
        tile_of(L, nM, nN, u.pm, u.pn);
        int e = 0;
        for (int j = 1; j < NE; ++j) e += (tstart[j] <= u.pm) ? 1 : 0;
        e = __builtin_amdgcn_readfirstlane(e);
        u.e = e; u.pb = e * nN + u.pn;
        u.row0 = __builtin_amdgcn_readfirstlane((u.pm - tstart[e]) * BM); u.cnt = __builtin_amdgcn_readfirstlane(cnt[e]);
        return true;
    }
    __device__ __forceinline__ int arow(const Unit& u, int r) const {
        if (!GATHER) return u.pm * BM + r;
        const int pos = u.row0 + r;
        return list[(size_t)u.e * LIST_CAP + (pos < u.cnt ? pos : 0)];
    }
    static constexpr bool PREFETCH = GATHER;
    LAS int* pf;
    __device__ __forceinline__ void issue_prefetch(const Unit& u, int lane) const {
        const char* src = (const char*)(list + (size_t)u.e * LIST_CAP + u.row0);
        __builtin_amdgcn_global_load_lds((const unsigned*)(src + (unsigned)(lane * 16)), (LAS unsigned*)pf, 16, 0, 0);
    }
    __device__ __forceinline__ int arow_pf(const Unit& u, int r) const {
        if (!GATHER) return u.pm * BM + r;
        const int v = pf[r];
        return (u.row0 + r < u.cnt) ? v : 0;
    }
};

template <class Epi, class Sched, bool ALIGN_EPI>
__device__ __forceinline__ void gemm_phase(LAS unsigned char* lds, const Gemm g, const Sched& S, const Epi& E) {
    const int tid = threadIdx.x, wid = __builtin_amdgcn_readfirstlane(tid >> 6), lane = tid & 63, wr = wid >> 2, wc = wid & 3, fr = lane & 15, fq = lane >> 4;
    const int K = g.K, nt = K / BK, lda = g.lda;
    unsigned voffB[2];
#pragma unroll
    for (int i = 0; i < 2; ++i) { int R_, C_; stage_rc(tid * 16 + i * 8192, R_, C_); const int Rb = Epi::PERM ? ((R_ & ~31) + perm32(R_ & 31)) : R_; voffB[i] = (unsigned)(Rb * K + C_) * 2u; }
    const size_t kstep = (size_t)(BK * 2);
    const size_t hstepB = (size_t)HALF * K * 2, tstepB = 2 * hstepB;
    const unsigned ldsw = (unsigned)wid * 1024u;
    const int aoff = lds_byte(wr * 64 + fr, fq * 8), boff = lds_byte(wc * 32 + fr, fq * 8);
#define PG8_SA(b, h) (((b) * 2 + (h)) * HTB)
#define PG8_SB(b, h) ((4 + (b) * 2 + (h)) * HTB)
#define PG8_STAGE(bufoff, gbase, voff) do { _Pragma("unroll") for (int _i = 0; _i < 2; ++_i) \
        __builtin_amdgcn_global_load_lds((const unsigned*)((const char*)(gbase) + (voff)[_i]), (LAS unsigned*)(lds + (bufoff) + ldsw + _i * 8192), 16, 0, 0); } while (0)
#define PG8_LDA(dst, b, h) do { _Pragma("unroll") for (int m = 0; m < 4; ++m) _Pragma("unroll") for (int k = 0; k < 2; ++k) dst[m][k] = *(const LAS bf16x8*)(lds + PG8_SA(b, h) + aoff + m * 2048 + k * 1024); } while (0)
#define PG8_LDB(dst, b, h) do { _Pragma("unroll") for (int n = 0; n < 2; ++n) _Pragma("unroll") for (int k = 0; k < 2; ++k) dst[n][k] = *(const LAS bf16x8*)(lds + PG8_SB(b, h) + boff + n * 2048 + k * 1024); } while (0)
#define PG8_MMA(ai, bj, At, Bt) do { __builtin_amdgcn_s_setprio(1); _Pragma("unroll") for (int m = 0; m < 4; ++m) _Pragma("unroll") for (int n = 0; n < 2; ++n) _Pragma("unroll") for (int k = 0; k < 2; ++k) \
        acc[ai][bj][m][n] = __builtin_amdgcn_mfma_f32_16x16x32_bf16(Bt[n][k], At[m][k], acc[ai][bj][m][n], 0, 0, 0); __builtin_amdgcn_s_setprio(0); } while (0)
#define PG8_WAIT_V(n) asm volatile("s_waitcnt vmcnt(" #n ")" ::: "memory")
#define PG8_WAIT_L(n) asm volatile("s_waitcnt lgkmcnt(" #n ")" ::: "memory")
#define PG8_BAR __builtin_amdgcn_s_barrier()
#define PG8_SCHED __builtin_amdgcn_sched_barrier(0)
#define PG8_AOFF(dst, u) do { _Pragma("unroll") for (int _i = 0; _i < 2; ++_i) { int R_, C_; stage_rc(tid * 16 + _i * 8192, R_, C_); _Pragma("unroll") for (int _h = 0; _h < 2; ++_h) \
        dst[_h][_i] = ((unsigned)S.arow(u, _h * HALF + R_) * (unsigned)lda + (unsigned)C_) * 2u; } } while (0)
    Unit cur, nxt; int ui = 0;
    if (!S.next(0, cur)) return;
    f32x4 acc[2][2][4][2];
#pragma unroll
    for (int a = 0; a < 2; ++a)
#pragma unroll
        for (int b = 0; b < 2; ++b)
#pragma unroll
            for (int m = 0; m < 4; ++m)
#pragma unroll
                for (int n = 0; n < 2; ++n) acc[a][b][m][n] = (f32x4){0.f, 0.f, 0.f, 0.f};
    bf16x8 At[4][2], B0[2][2], B1[2][2];
    unsigned vA[2][2];
    PG8_AOFF(vA, cur);
    const char* const gA = (const char*)g.A;
    const char* cB = (const char*)g.Bt + (size_t)cur.pb * tstepB;
    PG8_STAGE(PG8_SB(0, 0), cB, voffB); PG8_STAGE(PG8_SB(0, 1), cB + hstepB, voffB); PG8_STAGE(PG8_SA(0, 0), gA, vA[0]); PG8_STAGE(PG8_SA(0, 1), gA, vA[1]);
    if (wr == 1) PG8_BAR;
    PG8_WAIT_V(2); PG8_BAR;
    PG8_STAGE(PG8_SB(1, 0), cB + kstep, voffB); PG8_STAGE(PG8_SA(1, 0), gA + kstep, vA[0]); PG8_STAGE(PG8_SB(1, 1), cB + hstepB + kstep, voffB);
    PG8_WAIT_V(6); PG8_BAR;
    for (;;) {
        const bool has_next = S.next(ui + 1, nxt);
        const char* nB = has_next ? (const char*)g.Bt + (size_t)nxt.pb * tstepB : cB;
        _Pragma("nounroll") for (int t = 0; t < nt; t += 2) {
            const bool last = (t == nt - 2);
            const char* a1 = gA + (size_t)(t + 1) * kstep;
            const char* a2 = last ? gA : gA + (size_t)(t + 2) * kstep; const char* b2 = last ? nB : cB + (size_t)(t + 2) * kstep;
            const char* a3 = a2 + kstep; const char* b3 = b2 + kstep;
            PG8_LDB(B0, 0, 0); PG8_LDB(B1, 0, 1); PG8_SCHED; PG8_LDA(At, 0, 0); PG8_STAGE(PG8_SA(1, 1), a1, vA[1]);
            PG8_WAIT_V(8); PG8_WAIT_L(0); PG8_BAR; PG8_MMA(0, 0, At, B0); PG8_MMA(0, 1, At, B1); PG8_BAR; PG8_SCHED;
            if constexpr (Sched::PREFETCH) { if (t == 0 && has_next && wid == 0) S.issue_prefetch(nxt, lane); }
            if (last && has_next) {
#pragma unroll
                for (int i = 0; i < 2; ++i) { int R_, C_; stage_rc(tid * 16 + i * 8192, R_, C_);
#pragma unroll
                    for (int h = 0; h < 2; ++h) vA[h][i] = ((unsigned)S.arow_pf(nxt, h * HALF + R_) * (unsigned)lda + (unsigned)C_) * 2u; } }
            PG8_LDA(At, 0, 1); PG8_STAGE(PG8_SB(0, 0), b2, voffB); PG8_STAGE(PG8_SB(0, 1), b2 + hstepB, voffB); PG8_STAGE(PG8_SA(0, 0), a2, vA[0]);
            PG8_WAIT_V(8); PG8_WAIT_L(0); PG8_BAR; PG8_MMA(1, 0, At, B0); PG8_MMA(1, 1, At, B1); PG8_BAR; PG8_SCHED;
            PG8_LDB(B0, 1, 0); PG8_LDB(B1, 1, 1); PG8_SCHED; PG8_LDA(At, 1, 0); PG8_STAGE(PG8_SA(0, 1), a2, vA[1]);
            PG8_WAIT_V(8); PG8_WAIT_L(0); PG8_BAR; PG8_MMA(0, 0, At, B0); PG8_MMA(0, 1, At, B1); PG8_BAR; PG8_SCHED;
            PG8_LDA(At, 1, 1); PG8_STAGE(PG8_SB(1, 0), b3, voffB); PG8_STAGE(PG8_SB(1, 1), b3 + hstepB, voffB); PG8_STAGE(PG8_SA(1, 0), a3, vA[0]);
            PG8_WAIT_V(8); PG8_WAIT_L(0); PG8_BAR; PG8_MMA(1, 0, At, B0); PG8_MMA(1, 1, At, B1); PG8_BAR; PG8_SCHED;
        }
        if constexpr (ALIGN_EPI) { if (wr == 0) PG8_BAR; }
        E(acc, cur, wr, wc, fr, fq);
        if (!has_next) break;
#pragma unroll
        for (int a = 0; a < 2; ++a)
#pragma unroll
            for (int b = 0; b < 2; ++b)
#pragma unroll
                for (int m = 0; m < 4; ++m)
#pragma unroll
                    for (int n = 0; n < 2; ++n) acc[a][b][m][n] = (f32x4){0.f, 0.f, 0.f, 0.f};
        cur = nxt; cB = nB; ++ui;
        if constexpr (ALIGN_EPI) { if (wr == 1) PG8_BAR; }
    }
    PG8_WAIT_V(0);
    if constexpr (!ALIGN_EPI) { if (wr == 0) PG8_BAR; }
    PG8_BAR;
#undef PG8_SA
#undef PG8_SB
#undef PG8_STAGE
#undef PG8_LDA
#undef PG8_LDB
#undef PG8_MMA
#undef PG8_WAIT_V
#undef PG8_WAIT_L
#undef PG8_BAR
#undef PG8_SCHED
#undef PG8_AOFF
}

typedef const f32x4 (&AccRef)[2][2][4][2];
__device__ __forceinline__ u32x4 pack8(f32x4 a, f32x4 b) { u32x4 w; w.x = pk_bf16(a[0], a[1]); w.y = pk_bf16(a[2], a[3]); w.z = pk_bf16(b[0], b[1]); w.w = pk_bf16(b[2], b[3]); return w; }
__device__ __forceinline__ void unpack8(u32x4 w, f32x4& a, f32x4& b) { a = (f32x4){bf_lo(w.x), bf_hi(w.x), bf_lo(w.y), bf_hi(w.y)}; b = (f32x4){bf_lo(w.z), bf_hi(w.z), bf_lo(w.w), bf_hi(w.w)}; }

struct EpiProj {
    static constexpr bool PERM = true;
    bf16_t* P; float* ssq_q; float* ssq_kv;
    __device__ __forceinline__ void operator()(AccRef acc, const Unit& u, int wr, int wc, int fr, int fq) const {
        const int row0 = u.pm * BM + wr * 64 + fr, col0 = u.pn * BM + wc * 32 + 8 * fq;
#pragma unroll
        for (int ai = 0; ai < 2; ++ai)
#pragma unroll
            for (int m = 0; m < 4; ++m) { bf16_t* rowp = P + (size_t)(row0 + ai * HALF + m * 16) * NPROJ + col0;
#pragma unroll
                for (int bj = 0; bj < 2; ++bj) *(u32x4*)(rowp + bj * HALF) = pack8(acc[ai][bj][m][0], acc[ai][bj][m][1]); }
#pragma unroll
        for (int bj = 0; bj < 2; ++bj) { const int hh = 2 * u.pn + bj;
            if (hh >= OFF_QL / 128 && hh < OFF_KPE / 128) { float* dst = (hh < OFF_KVL / 128) ? ssq_q : ssq_kv;
#pragma unroll
                for (int ai = 0; ai < 2; ++ai)
#pragma unroll
                    for (int m = 0; m < 4; ++m) { const f32x4 a = acc[ai][bj][m][0], b = acc[ai][bj][m][1];
                        float s = (a[0] * a[0] + a[1] * a[1]) + (a[2] * a[2] + a[3] * a[3]) + (b[0] * b[0] + b[1] * b[1]) + (b[2] * b[2] + b[3] * b[3]);
                        s += __shfl_xor(s, 16); s += __shfl_xor(s, 32);
                        if (fq == 0) atomicAdd(dst + row0 + ai * HALF + m * 16, s); } } }
    }
};
struct EpiNull {
    static constexpr bool PERM = true;
    __device__ __forceinline__ void operator()(AccRef acc, const Unit& u, int wr, int wc, int fr, int fq) const {
#pragma unroll
        for (int ai = 0; ai < 2; ++ai)
#pragma unroll
            for (int bj = 0; bj < 2; ++bj)
#pragma unroll
                for (int m = 0; m < 4; ++m)
#pragma unroll
                    for (int n = 0; n < 2; ++n) asm volatile("" :: "v"(acc[ai][bj][m][n]));
    }
};
struct EpiQ {
    static constexpr bool PERM = true;
    bf16_t* Q; const float* ssq; const float* cs; const float* sn;
    __device__ __forceinline__ void operator()(AccRef acc, const Unit& u, int wr, int wc, int fr, int fq) const {
        const int row0 = u.pm * BM + wr * 64 + fr;
        if (u.pn < 4) {
#pragma unroll
            for (int ai = 0; ai < 2; ++ai)
#pragma unroll
                for (int m = 0; m < 4; ++m) { const int row = row0 + ai * HALF + m * 16;
                    const float rs = __builtin_amdgcn_rsqf(ssq[row] * (1.0f / QL) + RMS_EPS) * QSCALE;
#pragma unroll
                    for (int bj = 0; bj < 2; ++bj) { bf16_t* dst = Q + (size_t)row * (NH * DQK) + (2 * u.pn + bj) * DQK + wc * 32 + 8 * fq;
                        *(u32x4*)dst = pack8(acc[ai][bj][m][0] * rs, acc[ai][bj][m][1] * rs); } }
        } else {
            const int head = 4 * (u.pn - 4) + wc, i0 = 8 * fq;
#pragma unroll
            for (int ai = 0; ai < 2; ++ai)
#pragma unroll
                for (int m = 0; m < 4; ++m) { const int row = row0 + ai * HALF + m * 16;
                    const float rs = __builtin_amdgcn_rsqf(ssq[row] * (1.0f / QL) + RMS_EPS) * QSCALE;
                    const f32x4 c0 = *(const f32x4*)(cs + (size_t)row * 32 + i0), c1 = *(const f32x4*)(cs + (size_t)row * 32 + i0 + 4);
                    const f32x4 s0 = *(const f32x4*)(sn + (size_t)row * 32 + i0), s1 = *(const f32x4*)(sn + (size_t)row * 32 + i0 + 4);
                    const f32x4 x10 = acc[ai][0][m][0] * rs, x11 = acc[ai][0][m][1] * rs, x20 = acc[ai][1][m][0] * rs, x21 = acc[ai][1][m][1] * rs;
                    bf16_t* dst = Q + (size_t)row * (NH * DQK) + head * DQK + DN + i0;
                    *(u32x4*)dst = pack8(x10 * c0 - x20 * s0, x11 * c1 - x21 * s1);
                    *(u32x4*)(dst + 32) = pack8(x10 * s0 + x20 * c0, x11 * s1 + x21 * c1);
                    asm volatile("" ::: "memory"); }
        }
    }
};
struct EpiKV {
    static constexpr bool PERM = true;
    bf16_t* KN; bf16_t* V; const float* ssq;
    __device__ __forceinline__ void operator()(AccRef acc, const Unit& u, int wr, int wc, int fr, int fq) const {
        const int row0 = u.pm * BM + wr * 64 + fr; bf16_t* base = (u.pn < 4) ? KN : V; const int col0 = (u.pn & 3) * BM + wc * 32 + 8 * fq;
#pragma unroll
        for (int ai = 0; ai < 2; ++ai)
#pragma unroll
            for (int m = 0; m < 4; ++m) { const int row = row0 + ai * HALF + m * 16;
                const float rs = __builtin_amdgcn_rsqf(ssq[row] * (1.0f / KVL) + RMS_EPS);
#pragma unroll
                for (int bj = 0; bj < 2; ++bj) *(u32x4*)(base + (size_t)row * 1024 + col0 + bj * HALF) = pack8(acc[ai][bj][m][0] * rs, acc[ai][bj][m][1] * rs); }
    }
};
struct EpiGate2 {
    static constexpr bool PERM = true;
    bf16_t* YC; bf16_t* MG; const bf16_t* P;
    __device__ __forceinline__ void operator()(AccRef acc, const Unit& u, int wr, int wc, int fr, int fq) const {
        const int row0 = u.pm * BM + wr * 64 + fr, col0 = u.pn * BM + wc * 32 + 8 * fq;
        const bool merge = u.e != 0; const int goff = merge ? OFF_GATTN : OFF_GCONV; bf16_t* O = merge ? MG : YC;
#pragma unroll
        for (int ai = 0; ai < 2; ++ai)
#pragma unroll
            for (int m = 0; m < 4; ++m) { const size_t row = (size_t)(row0 + ai * HALF + m * 16);
#pragma unroll
                for (int bj = 0; bj < 2; ++bj) { const int col = col0 + bj * HALF;
                    const u32x4 gw = *(const u32x4*)(P + row * NPROJ + goff + col); f32x4 g0, g1; unpack8(gw, g0, g1);
                    f32x4 v0 = acc[ai][bj][m][0], v1 = acc[ai][bj][m][1];
#pragma unroll
                    for (int j = 0; j < 4; ++j) { v0[j] *= sigmoidf_(g0[j]); v1[j] *= sigmoidf_(g1[j]); }
                    if (merge) { const u32x4 yw = *(const u32x4*)(YC + row * DM + col); f32x4 y0, y1; unpack8(yw, y0, y1); v0 += y0; v1 += y1; }
                    *(u32x4*)(O + row * DM + col) = pack8(v0, v1); } }
    }
};
struct EpiH1 {
    static constexpr bool PERM = false;
    float* H; const float* X;
    __device__ __forceinline__ void operator()(AccRef acc, const Unit& u, int wr, int wc, int fr, int fq) const {
        const int row0 = u.pm * BM + wr * 64 + fr, col0 = u.pn * BM + wc * 32 + 4 * fq;
#pragma unroll
        for (int ai = 0; ai < 2; ++ai)
#pragma unroll
            for (int m = 0; m < 4; ++m) { const size_t off = (size_t)(row0 + ai * HALF + m * 16) * DM + col0;
#pragma unroll
                for (int bj = 0; bj < 2; ++bj)
#pragma unroll
                    for (int n = 0; n < 2; ++n) { const f32x4 x = *(const f32x4*)(X + off + bj * HALF + n * 16); *(f32x4*)(H + off + bj * HALF + n * 16) = x * DN_ALPHA + acc[ai][bj][m][n]; } }
    }
};
struct EpiGU {
    static constexpr bool PERM = true;
    bf16_t* HID; const float* bias;
    __device__ __forceinline__ void operator()(AccRef acc, const Unit& u, int wr, int wc, int fr_, int fq_) const {
        int ln = fr_ | (fq_ << 4); asm volatile("" : "+v"(ln));
        const int fr = ln & 15, fq = ln >> 4;
        const char* bbase = (const char*)(bias + (size_t)u.e * (2 * DFF) + u.pn * HALF); const unsigned boff = (unsigned)(wc * 32 + 8 * fq) * 4u;
        const f32x4 bg0 = *(const f32x4*)(bbase + boff), bg1 = *(const f32x4*)(bbase + boff + 16), bu0 = *(const f32x4*)(bbase + boff + DFF * 4), bu1 = *(const f32x4*)(bbase + boff + DFF * 4 + 16);
        char* hbase = (char*)(HID + (size_t)u.pm * BM * DFF + u.pn * HALF); const unsigned hoff = (unsigned)((wr * 64 + fr) * DFF + wc * 32 + 8 * fq) * 2u;
#pragma unroll
        for (int ai = 0; ai < 2; ++ai)
#pragma unroll
            for (int m = 0; m < 4; ++m) { f32x4 g0 = acc[ai][0][m][0] + bg0, g1 = acc[ai][0][m][1] + bg1, u0 = acc[ai][1][m][0] + bu0, u1 = acc[ai][1][m][1] + bu1;
#pragma unroll
                for (int j = 0; j < 4; ++j) {
                    float g = fminf(g0[j], SWI_LIMIT), up = fminf(fmaxf(u0[j], -SWI_LIMIT), SWI_LIMIT); g0[j] = (up + 1.0f) * (g * sigmoidf_(SWI_ALPHA * g));
                    g = fminf(g1[j], SWI_LIMIT); up = fminf(fmaxf(u1[j], -SWI_LIMIT), SWI_LIMIT); g1[j] = (up + 1.0f) * (g * sigmoidf_(SWI_ALPHA * g)); }
                *(u32x4*)(hbase + hoff + (unsigned)((ai * HALF + m * 16) * DFF * 2)) = pack8(g0, g1); }
    }
};
struct EpiDown {
    static constexpr bool PERM = true;
    bf16_t* EO; const float* bias;
    __device__ __forceinline__ void operator()(AccRef acc, const Unit& u, int wr, int wc, int fr, int fq) const {
        const int row0 = u.pm * BM + wr * 64 + fr, col0 = u.pn * BM + wc * 32 + 8 * fq;
        f32x4 bv[2][2];
#pragma unroll
        for (int bj = 0; bj < 2; ++bj)
#pragma unroll
            for (int n = 0; n < 2; ++n) bv[bj][n] = *(const f32x4*)(bias + (size_t)u.e * DM + col0 + bj * HALF + 4 * n);
#pragma unroll
        for (int ai = 0; ai < 2; ++ai)
#pragma unroll
            for (int m = 0; m < 4; ++m) { bf16_t* rowp = EO + (size_t)(row0 + ai * HALF + m * 16) * DM + col0;
#pragma unroll
                for (int bj = 0; bj < 2; ++bj) *(u32x4*)(rowp + bj * HALF) = pack8(acc[ai][bj][m][0] + bv[bj][0], acc[ai][bj][m][1] + bv[bj][1]); }
    }
};
}

namespace att {
constexpr int NW = 8, QBLK = 32, KVBLK = 64;
constexpr int LDQ = NH * DQK, LDK = NH * DN, LDP = DR, LDO = NH * DV;
constexpr int SHM_V = KVBLK * DV * 2, SHM_KN = KVBLK * DN * 2, SHM_KP = KVBLK * DR * 2;
constexpr int OFF_V = 0, OFF_KN = 2 * SHM_V, OFF_KP = OFF_KN + 2 * SHM_KN, OFF_WS = OFF_KP + 2 * SHM_KP, ATT_LDS = OFF_WS + NW * 64 * 4;
static_assert(ATT_LDS <= RING_BYTES && MISC_OFF + 768 + 2048 <= LDS_BYTES && 8 * 16896 <= MISC_OFF, "LDS map");
constexpr float THR = 8.0f;
#define KSWZ(row, colB) ((row) * 256 + ((colB) ^ (((row) & 7) << 4)))
#define PSWZ(row, colB) ((row) * 128 + ((colB) ^ (((row) & 7) << 4)))
#define SBAR() __builtin_amdgcn_sched_barrier(0)
__device__ __forceinline__ int crow(int r, int hi) { return (r & 3) + 8 * (r >> 2) + 4 * hi; }

__device__ __forceinline__ void partialSM(f32x16& p0, f32x16& p1, float& m_reg, float& mn, float& alpha) {
    float pmax = p0[0];
#pragma unroll
    for (int r = 1; r < 16; ++r) pmax = fmaxf(pmax, p0[r]);
#pragma unroll
    for (int r = 0; r < 16; ++r) pmax = fmaxf(pmax, p1[r]);
    { auto rr = __builtin_amdgcn_permlane32_swap(__float_as_uint(pmax), __float_as_uint(pmax), false, false); pmax = fmaxf(__uint_as_float(rr[0]), __uint_as_float(rr[1])); }
    if (__builtin_expect(__all(pmax - m_reg <= THR), 1)) { mn = m_reg; alpha = 1.f; }
    else { mn = fmaxf(m_reg, pmax); alpha = __builtin_amdgcn_exp2f(m_reg - mn); m_reg = mn; }
#pragma unroll
    for (int r = 0; r < 16; ++r) { p0[r] -= mn; p1[r] -= mn; }
#pragma unroll
    for (int r = 0; r < 16; ++r) p0[r] = __builtin_amdgcn_exp2f(p0[r]);
}
__device__ __forceinline__ void finishSM(f32x16& p0, f32x16& p1, float alpha, float& l_reg, bf16x8& pa0, bf16x8& pa1, bf16x8& pa2, bf16x8& pa3) {
#pragma unroll
    for (int r = 0; r < 16; ++r) p1[r] = __builtin_amdgcn_exp2f(p1[r]);
    float ps = 0;
#pragma unroll
    for (int r = 0; r < 16; ++r) ps += p0[r];
#pragma unroll
    for (int r = 0; r < 16; ++r) ps += p1[r];
    { auto rr = __builtin_amdgcn_permlane32_swap(__float_as_uint(ps), __float_as_uint(ps), false, false); ps = __uint_as_float(rr[0]) + __uint_as_float(rr[1]); }
    l_reg = l_reg * alpha + ps;
#define PK4(P, BASE, OUT) do { unsigned a0 = pk_bf16(P[BASE + 0], P[BASE + 1]), a1 = pk_bf16(P[BASE + 2], P[BASE + 3]);   \
    unsigned b0 = pk_bf16(P[BASE + 4], P[BASE + 5]), b1 = pk_bf16(P[BASE + 6], P[BASE + 7]);                              \
    auto r0 = __builtin_amdgcn_permlane32_swap(a0, b0, false, false); auto r1 = __builtin_amdgcn_permlane32_swap(a1, b1, false, false); \
    u32x4 w = {r0[0], r1[0], r0[1], r1[1]}; OUT = __builtin_bit_cast(bf16x8, w); } while (0)
    PK4(p0, 0, pa0); PK4(p0, 8, pa1); PK4(p1, 0, pa2); PK4(p1, 8, pa3);
#undef PK4
}
__device__ __forceinline__ void qkt(f32x16& p0, f32x16& p1, const LAS unsigned char* Kn, const LAS unsigned char* Kp, const bf16x8* qr, const int* kx, const int* px, bool masked) {
    p0 = f32x16{}; p1 = f32x16{};
#pragma unroll
    for (int d0 = 0; d0 < 8; ++d0) {
        const bf16x8 b0 = *(const LAS bf16x8*)(Kn + kx[d0 & 3] + (d0 >> 2) * 128);
        const bf16x8 b1 = *(const LAS bf16x8*)(Kn + kx[d0 & 3] + (d0 >> 2) * 128 + 8192);
        p0 = __builtin_amdgcn_mfma_f32_32x32x16_bf16(b0, qr[d0], p0, 0, 0, 0);
        p1 = __builtin_amdgcn_mfma_f32_32x32x16_bf16(b1, qr[d0], p1, 0, 0, 0); }
#pragma unroll
    for (int d0 = 0; d0 < 4; ++d0) {
        const bf16x8 b0 = *(const LAS bf16x8*)(Kp + px[d0]);
        const bf16x8 b1 = *(const LAS bf16x8*)(Kp + px[d0] + 4096);
        p0 = __builtin_amdgcn_mfma_f32_32x32x16_bf16(b0, qr[8 + d0], p0, 0, 0, 0);
        p1 = __builtin_amdgcn_mfma_f32_32x32x16_bf16(b1, qr[8 + d0], p1, 0, 0, 0); }
    if (masked) {
#pragma unroll
        for (int r = 0; r < 16; ++r) { p0[r] = -INFINITY; p1[r] = -INFINITY; } }
}
__device__ __forceinline__ int v_st(int k, int c) { const int kk = (k & ~0xC) | ((k & 4) << 1) | ((k & 8) >> 1); return ((kk >> 3) * 4 + (c >> 5)) * 512 + ((kk & 7) * 32 + (c & 31)) * 2; }
__device__ __forceinline__ int v_rd_base(int lane) { return ((lane & 3) << 3) | (((lane >> 2) & 3) << 6) | (((lane >> 4) & 1) << 5) | (((lane >> 5) & 1) << 8); }
constexpr int v_rd_off(int d0, int ks, int half) { return d0 * 512 + ks * 4096 + half * 2048; }
template <int OFF> __device__ __forceinline__ s16x4 tr_read(int vb) { s16x4 r; asm volatile("ds_read_b64_tr_b16 %0, %1 offset:%2" : "=&v"(r) : "v"(vb), "i"(OFF) : "memory"); return r; }
template <int D0> __device__ __forceinline__ void pv_one(f32x16& od, int vb, bf16x8 pa0, bf16x8 pa1, bf16x8 pa2, bf16x8 pa3) {
    const s16x4 l0 = tr_read<v_rd_off(D0, 0, 0)>(vb), h0 = tr_read<v_rd_off(D0, 0, 1)>(vb), l1 = tr_read<v_rd_off(D0, 1, 0)>(vb), h1 = tr_read<v_rd_off(D0, 1, 1)>(vb);
    const s16x4 l2 = tr_read<v_rd_off(D0, 2, 0)>(vb), h2 = tr_read<v_rd_off(D0, 2, 1)>(vb), l3 = tr_read<v_rd_off(D0, 3, 0)>(vb), h3 = tr_read<v_rd_off(D0, 3, 1)>(vb);
    asm volatile("s_waitcnt lgkmcnt(0)" ::: "memory"); SBAR();
#define PK(L, H) (bf16x8){L[0], L[1], L[2], L[3], H[0], H[1], H[2], H[3]}
    od = __builtin_amdgcn_mfma_f32_32x32x16_bf16(pa0, PK(l0, h0), od, 0, 0, 0);
    od = __builtin_amdgcn_mfma_f32_32x32x16_bf16(pa1, PK(l1, h1), od, 0, 0, 0);
    od = __builtin_amdgcn_mfma_f32_32x32x16_bf16(pa2, PK(l2, h2), od, 0, 0, 0);
    od = __builtin_amdgcn_mfma_f32_32x32x16_bf16(pa3, PK(l3, h3), od, 0, 0, 0);
#undef PK
}
__device__ __forceinline__ void pv_d0(f32x16* o, int vb, bf16x8 pa0, bf16x8 pa1, bf16x8 pa2, bf16x8 pa3) {
    pv_one<0>(o[0], vb, pa0, pa1, pa2, pa3); pv_one<1>(o[1], vb, pa0, pa1, pa2, pa3); pv_one<2>(o[2], vb, pa0, pa1, pa2, pa3); pv_one<3>(o[3], vb, pa0, pa1, pa2, pa3);
}

__device__ __forceinline__ void attn_unit(int b, int h, int qb, const bf16_t* __restrict__ Q, const bf16_t* __restrict__ KN, const bf16_t* __restrict__ KP, const bf16_t* __restrict__ V, bf16_t* __restrict__ O, LAS unsigned char* lds) {
    const int tid = threadIdx.x, wid = __builtin_amdgcn_readfirstlane(tid >> 6), lane = tid & 63, r32 = lane & 31, hi = lane >> 5;
    LAS float* ws = (LAS float*)(lds + OFF_WS) + wid * 64; LAS float* li_l = ws; LAS float* al_l = ws + 32;
    const size_t rowbase = (size_t)b * SEQ; const int q0 = qb * (QBLK * NW);
    float m_reg = -1e30f, l_reg = 0; f32x16 o[4] = {}; bf16x8 qr[12];
    { const char* qbase = (const char*)(Q + (rowbase + q0 + wid * QBLK) * LDQ + h * DQK); const unsigned qoff = (unsigned)(r32 * LDQ + hi * 8) * 2u;
#pragma unroll
      for (int d0 = 0; d0 < 12; ++d0) qr[d0] = *reinterpret_cast<const bf16x8*>(qbase + qoff + d0 * 32); }
    const bf16_t* Kh = KN + rowbase * LDK + h * DN; const bf16_t* Vh = V + rowbase * LDK + h * DV; const bf16_t* Ph = KP + rowbase * LDP;
    unsigned gk0, gp0, gv0;
    { const int row = wid * 4 + (lane >> 4); gk0 = (unsigned)(row * (LDK * 2) + (((lane & 15) ^ (row & 7)) << 4)); }
    { const int row = wid * 8 + (lane >> 3); gp0 = (unsigned)(row * (LDP * 2) + (((lane & 7) ^ (row & 7)) << 4)); }
    { const int st = 2 * wid + (lane >> 5), q = lane & 31, kk = (st >> 2) * 8 + (q >> 2), c = (st & 3) * 32 + (q & 3) * 8, k = (kk & ~0xC) | ((kk & 4) << 1) | ((kk & 8) >> 1); gv0 = (unsigned)(k * (LDK * 2) + c * 2); }
    const unsigned ldsw = (unsigned)wid * 1024u;
#define GLDS(src, dst) __builtin_amdgcn_global_load_lds((const unsigned*)(src), (LAS unsigned*)(dst), 16, 0, 0)
#define DMA_K(j, bb) do { const char* kt_ = (const char*)(Kh + (size_t)(j) * KVBLK * LDK); const char* pt_ = (const char*)(Ph + (size_t)(j) * KVBLK * LDP); \
    GLDS(kt_ + gk0, lds + OFF_KN + (bb) * SHM_KN + ldsw); GLDS(kt_ + gk0 + 32 * LDK * 2, lds + OFF_KN + (bb) * SHM_KN + 8192 + ldsw); GLDS(pt_ + gp0, lds + OFF_KP + (bb) * SHM_KP + ldsw); } while (0)
#define DMA_V(j, bb) do { const char* vt_ = (const char*)(Vh + (size_t)(j) * KVBLK * LDK); \
    GLDS(vt_ + gv0, lds + OFF_V + (bb) * SHM_V + ldsw); GLDS(vt_ + gv0 + 32 * LDK * 2, lds + OFF_V + (bb) * SHM_V + 8192 + ldsw); } while (0)
#define STEP_END() do { asm volatile("s_waitcnt vmcnt(0) lgkmcnt(0)" ::: "memory"); __builtin_amdgcn_s_barrier(); asm volatile("" ::: "memory"); } while (0)
#define RESC(a) do { if (__any((a) < 1.f)) { if (hi == 0) al_l[r32] = (a); asm volatile("s_waitcnt lgkmcnt(0)" ::: "memory"); \
    _Pragma("unroll") for (int d = 0; d < 4; ++d) _Pragma("unroll") for (int r = 0; r < 16; ++r) o[d][r] *= al_l[crow(r, hi)]; } } while (0)
    int kx[4], px[4];
#pragma unroll
    for (int q = 0; q < 4; ++q) { kx[q] = r32 * 256 + (((2 * q + hi) ^ (r32 & 7)) << 4); px[q] = r32 * 128 + (((2 * q + hi) ^ (r32 & 7)) << 4); }
    const LAS unsigned char* K0 = lds + OFF_KN; const LAS unsigned char* K1 = lds + OFF_KN + SHM_KN; const LAS unsigned char* P0 = lds + OFF_KP; const LAS unsigned char* P1 = lds + OFF_KP + SHM_KP;
    const int vb0 = (int)(uintptr_t)(lds + OFF_V) + v_rd_base(lane);
    const int NT = 4 * qb + 4, jmax = 4 * qb + (wid >> 1);
    f32x16 pA0, pA1, pB0, pB1; float mnA, mnB, alA, alB; bf16x8 pa0, pa1, pa2, pa3;
    DMA_K(0, 0);
    STEP_END();
    DMA_K(1, 1); DMA_V(0, 0);
    qkt(pA0, pA1, K0, P0, qr, kx, px, false); partialSM(pA0, pA1, m_reg, mnA, alA);
    STEP_END();
    for (int j = 1; j + 1 < NT; j += 2) {
        DMA_K(j + 1, 0); DMA_V(j, 1);
        SBAR(); qkt(pB0, pB1, K1, P1, qr, kx, px, j > jmax);
        finishSM(pA0, pA1, alA, l_reg, pa0, pa1, pa2, pa3); SBAR();
        pv_d0(o, vb0, pa0, pa1, pa2, pa3); partialSM(pB0, pB1, m_reg, mnB, alB);
        RESC(alB);
        STEP_END();
        DMA_K(j + 2, 1); DMA_V(j + 1, 0);
        SBAR(); qkt(pA0, pA1, K0, P0, qr, kx, px, j + 1 > jmax);
        finishSM(pB0, pB1, alB, l_reg, pa0, pa1, pa2, pa3); SBAR();
        pv_d0(o, vb0 + SHM_V, pa0, pa1, pa2, pa3); partialSM(pA0, pA1, m_reg, mnA, alA);
        RESC(alA);
        STEP_END();
    }
    DMA_V(NT - 1, 1);
    SBAR(); qkt(pB0, pB1, K1, P1, qr, kx, px, NT - 1 > jmax);
    finishSM(pA0, pA1, alA, l_reg, pa0, pa1, pa2, pa3); SBAR();
    pv_d0(o, vb0, pa0, pa1, pa2, pa3); partialSM(pB0, pB1, m_reg, mnB, alB);
    RESC(alB);
    STEP_END();
    finishSM(pB0, pB1, alB, l_reg, pa0, pa1, pa2, pa3); SBAR();
    pv_d0(o, vb0 + SHM_V, pa0, pa1, pa2, pa3);
    if (hi == 0) li_l[r32] = l_reg;
    asm volatile("s_waitcnt lgkmcnt(0)" ::: "memory");
    float rli[16];
#pragma unroll
    for (int r = 0; r < 16; ++r) rli[r] = __builtin_amdgcn_rcpf(li_l[crow(r, hi)]);
    STEP_END();
    { LAS bf16_t* stg = (LAS bf16_t*)lds + wid * (QBLK * DV);
        int ln = lane; asm volatile("" : "+v"(ln));
        const int r32e = ln & 31, hie = ln >> 5;
#pragma unroll
        for (int r = 0; r < 16; ++r) { const int orow = crow(r, hie);
#pragma unroll
            for (int d0 = 0; d0 < 4; ++d0) stg[orow * DV + d0 * 32 + r32e] = (bf16_t)(pk_bf16(o[d0][r] * rli[r], 0.f) & 0xffffu); }
        asm volatile("s_waitcnt lgkmcnt(0)" ::: "memory");
        char* Ow = (char*)(O + (rowbase + q0 + wid * QBLK) * LDO + h * DV);
        const unsigned ooff = (unsigned)((ln >> 4) * LDO + (ln & 15) * 8) * 2u; const int soff = (ln >> 4) * DV + (ln & 15) * 8;
#pragma unroll
        for (int i = 0; i < 8; ++i) { const u32x4 v = *(const LAS u32x4*)(stg + soff + i * 4 * DV); *(u32x4*)(Ow + ooff + (unsigned)(i * 4 * LDO * 2)) = v; } }
    STEP_END();
#undef GLDS
#undef DMA_K
#undef DMA_V
#undef STEP_END
#undef RESC
}
#undef KSWZ
#undef PSWZ
#undef SBAR
}

#define XB_TMO      128
#define XB_XCNT(j)  (256  + 64 * (j))
#define XB_XSUB(j)  (1280 + 64 * (j))
#define XB_XGEN(j)  (2304 + 64 * (j))
#define XB_TOP      3328
#define XB_TOPGEN   3392
#define XCD_BAR_WORDS 3456
#define XB_SPIN_CAP (1u << 18)
__device__ __forceinline__ unsigned xb_ld(unsigned* p)              { return __hip_atomic_load(p, __ATOMIC_RELAXED, __HIP_MEMORY_SCOPE_AGENT); }
__device__ __forceinline__ unsigned xb_add(unsigned* p, unsigned v) { return __hip_atomic_fetch_add(p, v, __ATOMIC_RELAXED, __HIP_MEMORY_SCOPE_AGENT); }
__device__ __forceinline__ unsigned xb_xcc_id() { return (unsigned)__builtin_amdgcn_s_getreg((3 << 11) | 20) & 0xFu; }
#define XB_SPIN(cond, bar) do { unsigned _sp = 0; while (cond) { __builtin_amdgcn_s_sleep(1); \
    if ((++_sp & 255u) == 0u) { if (xb_ld(&(bar)[XB_TMO])) break; if (_sp > XB_SPIN_CAP) { atomicAdd(&(bar)[XB_TMO], 1u); break; } } } } while (0)
struct XcdBarrier { unsigned* bar; unsigned x; volatile LAS unsigned* st; };
__device__ __forceinline__ XcdBarrier xcd_barrier_post(unsigned* bar, volatile LAS unsigned* st) {
    XcdBarrier b; b.bar = bar; b.x = xb_xcc_id(); b.st = st;
    if (threadIdx.x == 0) (void)xb_add(&bar[XB_XCNT(b.x)], 1u);
    return b;
}
__device__ __forceinline__ void xcd_barrier_complete(unsigned* bar, unsigned x, unsigned& nloc, unsigned& nx) {
    const unsigned G = gridDim.x * gridDim.y * gridDim.z;
    unsigned sum, cnt, mine, sp = 0u;
    for (;;) {
        sum = 0u; cnt = 0u; mine = 0u;
#pragma unroll
        for (unsigned j = 0; j < 16; ++j) { const unsigned c = xb_ld(&bar[XB_XCNT(j)]); sum += c; cnt += (c > 0u) ? 1u : 0u; mine = (j == x) ? c : mine; }
        if (sum == G) break;
        __builtin_amdgcn_s_sleep(1);
        if ((++sp & 255u) == 0u) { if (xb_ld(&bar[XB_TMO])) break; if (sp > XB_SPIN_CAP) { atomicAdd(&bar[XB_TMO], 1u); break; } }
    }
    nloc = mine > 0u ? mine : 1u; nx = cnt > 0u ? cnt : 1u;
}
__device__ __forceinline__ void xcd_barrier(const XcdBarrier& b) {
    asm volatile("s_waitcnt vmcnt(0)" ::: "memory");
    __syncthreads();
    if (threadIdx.x == 0) {
        unsigned* bar = b.bar;
        __builtin_amdgcn_s_waitcnt(0);
        unsigned nloc = b.st[0], nx = b.st[1];
        if (nloc == 0u) { xcd_barrier_complete(bar, b.x, nloc, nx); b.st[0] = nloc; b.st[1] = nx; }
        const unsigned old = xb_add(&bar[XB_XSUB(b.x)], 1u);
        const unsigned gen = old / nloc;
        if (old + 1u == (gen + 1u) * nloc) {
            __builtin_amdgcn_fence(__ATOMIC_RELEASE, "agent");
            asm volatile("s_waitcnt vmcnt(0)" ::: "memory");
            const unsigned og = xb_add(&bar[XB_TOP], 1u);
            const unsigned tg = og / nx;
            if (og + 1u == (tg + 1u) * nx) xb_add(&bar[XB_TOPGEN], 1u);
            else XB_SPIN(xb_ld(&bar[XB_TOPGEN]) == tg, bar);
            __builtin_amdgcn_fence(__ATOMIC_ACQUIRE, "agent");
            xb_add(&bar[XB_XGEN(b.x)], 1u);
            asm volatile("s_waitcnt vmcnt(0)" ::: "memory");
        } else {
            XB_SPIN(xb_ld(&bar[XB_XGEN(b.x)]) == gen, bar);
            __builtin_amdgcn_fence(__ATOMIC_ACQUIRE, "agent");
            asm volatile("s_waitcnt vmcnt(0)" ::: "memory");
        }
    }
    __syncthreads();
}

template <bool NT = false> __device__ __forceinline__ void tr_load(f32x4 (&buf)[16], const float* __restrict__ W, int N, int k0, int n0, int lane) {
#pragma unroll
    for (int i = 0; i < 8; ++i) { const int kp = 4 * i + (lane >> 4), n = 4 * (lane & 15); const float* p = W + (size_t)(k0 + 2 * kp) * N + n0 + n;
        if (NT) { buf[2 * i] = __builtin_nontemporal_load((const f32x4*)p); buf[2 * i + 1] = __builtin_nontemporal_load((const f32x4*)(p + N)); } else { buf[2 * i] = *(const f32x4*)p; buf[2 * i + 1] = *(const f32x4*)(p + N); } }
}
template <bool NT = false> __device__ __forceinline__ void tr_store(const f32x4 (&buf)[16], int k0, bf16_t* __restrict__ WT, int Kd, size_t dlo, size_t dhi, const float* __restrict__ g, LAS unsigned* scr, int lane) {
#pragma unroll
    for (int i = 0; i < 8; ++i) { const int kp = 4 * i + (lane >> 4), n = 4 * (lane & 15), sw = 4 * (lane & 7);
        f32x4 a = buf[2 * i], b = buf[2 * i + 1];
        if (g) { a = a * g[k0 + 2 * kp]; b = b * g[k0 + 2 * kp + 1]; }
        LAS unsigned* s = scr + n * 32 + (kp ^ sw);
        s[0] = pk_bf16(a[0], b[0]); s[32] = pk_bf16(a[1], b[1]); s[64] = pk_bf16(a[2], b[2]); s[96] = pk_bf16(a[3], b[3]); }
    LDS_WAIT(); asm volatile("" ::: "memory");
    const int c = lane & 7;
#pragma unroll
    for (int j = 0; j < 8; ++j) { const int n = (lane >> 3) + 8 * j; const u32x4 o = *(const LAS u32x4*)(scr + n * 32 + 4 * (c ^ ((n >> 2) & 7)));
        const size_t drow = (n < 32) ? dlo + n : dhi + (n - 32);
        if (NT) __builtin_nontemporal_store(o, (u32x4*)(WT + drow * Kd + k0 + 8 * c)); else *(u32x4*)(WT + drow * Kd + k0 + 8 * c) = o; }
    LDS_WAIT(); asm volatile("" ::: "memory");
}
__device__ __forceinline__ void tr_item(const float* __restrict__ W, int N, int k0, int n0, bf16_t* __restrict__ WT, int Kd, size_t dlo, size_t dhi, const float* __restrict__ g, LAS unsigned* scr, int lane) {
    f32x4 buf[16]; tr_load(buf, W, N, k0, n0, lane); tr_store(buf, k0, WT, Kd, dlo, dhi, g, scr, lane);
}
constexpr int I_GU = NE * 16 * 32, I_DN = NE * 16 * 16, I_EXP = I_GU + I_DN;
struct ExpItem { const float* src; bf16_t* dst; int N, k0, n0, Kd; size_t d; };
__device__ __forceinline__ ExpItem exp_item(int r, const float* w_gu, const float* w_dn, bf16_t* WguT, bf16_t* WdT) {
    ExpItem it;
    if (r < I_GU) { const int e = r / 512, rr = r % 512, kb = rr / 32, nb = rr % 32; const int n0 = 64 * nb;
        it.d = (n0 < DFF) ? (size_t)(256 * (n0 / 128) + (n0 % 128)) : (size_t)(256 * ((n0 - DFF) / 128) + 128 + (n0 - DFF) % 128);
        it.src = w_gu + (size_t)e * DM * 2 * DFF; it.dst = WguT + (size_t)e * 2 * DFF * DM; it.N = 2 * DFF; it.k0 = 64 * kb; it.n0 = n0; it.Kd = DM; }
    else { r -= I_GU; const int e = r / 256, rr = r % 256, kb = rr / 16, nb = rr % 16;
        it.d = (size_t)(64 * nb); it.src = w_dn + (size_t)e * DFF * DM; it.dst = WdT + (size_t)e * DM * DFF; it.N = DM; it.k0 = 64 * kb; it.n0 = 64 * nb; it.Kd = DFF; }
    return it;
}
__device__ __forceinline__ void convert_experts(int cw, int ncw, const float* w_gu, const float* w_dn, bf16_t* WguT, bf16_t* WdT, LAS unsigned* scr, int lane) {
    f32x4 b0[16], b1[16], b2[16]; ExpItem i0, i1, i2;
    int r = cw; if (r >= I_EXP) return;
    i0 = exp_item(r, w_gu, w_dn, WguT, WdT); tr_load<true>(b0, i0.src, i0.N, i0.k0, i0.n0, lane);
    i1 = i0; if (r + ncw < I_EXP) { i1 = exp_item(r + ncw, w_gu, w_dn, WguT, WdT); tr_load<true>(b1, i1.src, i1.N, i1.k0, i1.n0, lane); }
    i2 = i0;
#define CE_STEP(BC, IC, BN, IN_) do { const int rn = r + 2 * ncw; if (rn < I_EXP) { IN_ = exp_item(rn, w_gu, w_dn, WguT, WdT); tr_load<true>(BN, IN_.src, IN_.N, IN_.k0, IN_.n0, lane); } \
        tr_store<true>(BC, IC.k0, IC.dst, IC.Kd, IC.d, IC.d + 32, nullptr, scr, lane); r += ncw; if (r >= I_EXP) return; } while (0)
    for (;;) { CE_STEP(b0, i0, b2, i2); CE_STEP(b1, i1, b0, i0); CE_STEP(b2, i2, b1, i1); }
#undef CE_STEP
}

struct Args { const void* in[22]; float* out; unsigned char* ws; int ph_lo, ph_hi; };

__global__ void __launch_bounds__(512, 2) mk_fwd(Args args) {
    extern __shared__ __attribute__((aligned(16))) unsigned char lds_raw[];
    LAS unsigned char* lds = (LAS unsigned char*)lds_raw;
    volatile LAS unsigned* MISC = (volatile LAS unsigned*)(lds + MISC_OFF);
    volatile LAS int* TST = (volatile LAS int*)(lds + MISC_OFF + 64);
    volatile LAS int* CNT = (volatile LAS int*)(lds + MISC_OFF + 256);
    const int tid = threadIdx.x, lane = tid & 63, wave = __builtin_amdgcn_readfirstlane(tid >> 6);
    const int G = gridDim.x, bx = blockIdx.x;
    const int vcu = (G % 8 == 0) ? (bx % 8) * (G / 8) + bx / 8 : bx;
    unsigned char* ws = args.ws;
    unsigned* ctl = (unsigned*)(ws + WS_CTL);
    const float* x = (const float*)args.in[0]; const int* positions = (const int*)args.in[1];
    const float* w_in = (const float*)args.in[2]; const float* conv_w = (const float*)args.in[3]; const float* q_norm_g = (const float*)args.in[4];
    const float* w_uq = (const float*)args.in[5]; const float* kv_norm_g = (const float*)args.in[6]; const float* w_uk = (const float*)args.in[7]; const float* w_uv = (const float*)args.in[8];
    const float* w_cb = (const float*)args.in[9]; const float* w_ab = (const float*)args.in[10]; const float* w_out = (const float*)args.in[11];
    const float* ln1_g = (const float*)args.in[12]; const float* ln1_b = (const float*)args.in[13]; const float* w_router = (const float*)args.in[14]; const float* b_router = (const float*)args.in[15];
    const float* w_gu = (const float*)args.in[16]; const float* b_gu = (const float*)args.in[17]; const float* w_dn = (const float*)args.in[18]; const float* b_dn = (const float*)args.in[19];
    const float* ln2_g = (const float*)args.in[20]; const float* ln2_b = (const float*)args.in[21];
    float* out = args.out;
    float* ssq_q = (float*)(ws + WS_SSQ); float* ssq_kv = ssq_q + T;
    bf16_t* XB = (bf16_t*)(ws + WS_XB); bf16_t* WinT = (bf16_t*)(ws + WS_WIN); bf16_t* WuqT = (bf16_t*)(ws + WS_WUQ); bf16_t* WkvT = (bf16_t*)(ws + WS_WKV);
    bf16_t* WcbT = (bf16_t*)(ws + WS_WCB); bf16_t* WabT = (bf16_t*)(ws + WS_WAB); bf16_t* WoutT = (bf16_t*)(ws + WS_WOUT);
    float* tab_cos = (float*)(ws + WS_TAB); float* tab_sin = tab_cos + (size_t)T * 32;
    bf16_t* KPE = (bf16_t*)(ws + WS_KPE);
    int* tope = (int*)(ws + WS_TOP); float* topw = (float*)(tope + (size_t)T * 4); int* tpos = (int*)(topw + (size_t)T * 4);
    int* list = (int*)(ws + WS_LIST);
    bf16_t* WguT = (bf16_t*)(ws + WS_WGU); bf16_t* WdT = (bf16_t*)(ws + WS_WD);
    bf16_t* PROJ = (bf16_t*)(ws + WS_PROJ); bf16_t* HID = (bf16_t*)(ws + WS_HID);
    bf16_t* Qb = (bf16_t*)(ws + WS_Q); bf16_t* KNb = (bf16_t*)(ws + WS_KN); bf16_t* Vb = (bf16_t*)(ws + WS_V); bf16_t* CI = (bf16_t*)(ws + WS_CI); bf16_t* EO = (bf16_t*)(ws + WS_EO);
    bf16_t* YC = (bf16_t*)(ws + WS_YC); bf16_t* AO = (bf16_t*)(ws + WS_AO); bf16_t* MG = (bf16_t*)(ws + WS_MG);
    float* H1 = (float*)(ws + WS_H1); float* X1F = (float*)(ws + WS_X1F); bf16_t* X1B = (bf16_t*)(ws + WS_X1B);
    unsigned* ecnt = ctl + CW_CNT;

    for (int u = tid; u < 256; u += 512) ((LAS unsigned*)(lds + MISC_OFF))[u] = 0u;
    __syncthreads();
    XcdBarrier bar; bar.bar = ctl + CW_BAR; bar.x = 0; bar.st = nullptr;
    if (N_LAUNCHES == 1) bar = xcd_barrier_post(ctl + CW_BAR, MISC);
    const int lo = args.ph_lo, hi = args.ph_hi;
#ifndef MK_PHASE_MASK
#define MK_PHASE_MASK 0xffff
#endif
#define IN(k) ((((MK_PHASE_MASK) >> (k)) & 1) && lo <= (k) && (k) < hi)
#define GRID_BAR(k) do { if (IN(k) && IN((k) + 1)) xcd_barrier(bar); } while (0)
    const int n_gemm1 = (G == 256) ? 184 : G;
    const int gw = vcu * 8 + wave, NGW = G * 8;
    const int gt = vcu * 512 + tid, NGT = G * 512;

    if (IN(0)) {
        LAS unsigned* scr = (LAS unsigned*)(lds + wave * 8192);
        constexpr int I_IN = 16 * 91, I_UQ = 6 * 24, I_UK = 4 * 16, I_UV = 4 * 16, I_SQ = 16 * 16;
        constexpr int NITEMS = I_IN + I_UQ + I_UK + I_UV + 3 * I_SQ;
        if (n_gemm1 == G) convert_experts(gw, NGW, w_gu, w_dn, WguT, WdT, scr, lane);
        for (int it = gw; it < NITEMS; it += NGW) {
            int r = it;
            if (r < I_IN) { const int kb = r / 91, nb = r % 91; tr_item(w_in, IN_DIM, 64 * kb, 64 * nb, WinT, DM, 64 * nb, 64 * nb + 32, nullptr, scr, lane); continue; } r -= I_IN;
            if (r < I_UQ) { const int kb = r / 24, nb = r % 24; const int n0 = 64 * nb, head = n0 / DQK, within = n0 % DQK;
                size_t dl, dh;
                if (within < DN) { dl = (size_t)(256 * (head / 2) + 128 * (head % 2) + within); dh = dl + 32; }
                else { dl = (size_t)(256 * (4 + head / 4) + 32 * (head % 4)); dh = dl + 128; }
                tr_item(w_uq, NH * DQK, 64 * kb, n0, WuqT, QL, dl, dh, q_norm_g, scr, lane); continue; } r -= I_UQ;
            if (r < I_UK) { const int kb = r / 16, nb = r % 16; tr_item(w_uk, NH * DN, 64 * kb, 64 * nb, WkvT, KVL, 64 * nb, 64 * nb + 32, kv_norm_g, scr, lane); continue; } r -= I_UK;
            if (r < I_UV) { const int kb = r / 16, nb = r % 16; tr_item(w_uv, NH * DV, 64 * kb, 64 * nb, WkvT, KVL, 1024 + 64 * nb, 1024 + 64 * nb + 32, kv_norm_g, scr, lane); continue; } r -= I_UV;
            { const int w = r / I_SQ, rr = r % I_SQ, kb = rr / 16, nb = rr % 16; const float* src = (w == 0) ? w_cb : (w == 1) ? w_ab : w_out; bf16_t* dst = (w == 0) ? WcbT : (w == 1) ? WabT : WoutT;
                tr_item(src, DM, 64 * kb, 64 * nb, dst, DM, 64 * nb, 64 * nb + 32, nullptr, scr, lane); }
        }
        for (int i = gt; i < (NPROJ - IN_DIM) * DM / 8; i += NGT) *(u32x4*)(WinT + (size_t)IN_DIM * DM + (size_t)i * 8) = (u32x4){0u, 0u, 0u, 0u};
        for (int i = gt; i < T * DM / 8; i += NGT) { const f32x4 a = *(const f32x4*)(x + (size_t)i * 8), b = *(const f32x4*)(x + (size_t)i * 8 + 4); *(u32x4*)(XB + (size_t)i * 8) = pg8::pack8(a, b); }
        for (int i = gt; i < T * 32; i += NGT) { const int t = i >> 5, f = i & 31; const float invf = powf(10000.0f, -(float)f / 32.0f); const float ang = (float)positions[t] * invf;
            float s, c; sincosf(ang, &s, &c); tab_cos[i] = c; tab_sin[i] = s; }
    }
    GRID_BAR(0);

    if (IN(1)) {
        if (bx < n_gemm1) {
            pg8::Gemm g{XB, WinT, DM, DM}; pg8::StaticOrder S; S.init(T, NPROJ, n_gemm1, bx);
            pg8::EpiProj E{PROJ, ssq_q, ssq_kv};
            pg8::gemm_phase<pg8::EpiProj, pg8::StaticOrder, true>(lds, g, S, E);
        } else {
            convert_experts((bx - n_gemm1) * 8 + wave, (G - n_gemm1) * 8, w_gu, w_dn, WguT, WdT, (LAS unsigned*)(lds + wave * 8192), lane);
        }
    }
    GRID_BAR(1);

    if (IN(2)) {
#ifndef DBG_P2
#define DBG_P2 15
#endif
        if (DBG_P2 & 1) { const int cg = (tid & 127) * 8, rs = tid >> 7;
          f32x4 w0a = *(const f32x4*)(conv_w + cg), w0b = *(const f32x4*)(conv_w + cg + 4), w1a = *(const f32x4*)(conv_w + DM + cg), w1b = *(const f32x4*)(conv_w + DM + cg + 4),
                w2a = *(const f32x4*)(conv_w + 2 * DM + cg), w2b = *(const f32x4*)(conv_w + 2 * DM + cg + 4);
          for (int it = vcu; it < T / 16; it += G) { const int t0 = it * 16 + rs * 4;
              f32x4 um2a = {0, 0, 0, 0}, um2b = um2a, um1a = um2a, um1b = um2a;
#pragma unroll
              for (int d = -2; d < 4; ++d) { const int t = t0 + d; f32x4 ua = {0, 0, 0, 0}, ub = ua;
                  if (d >= 0 || (t0 & (SEQ - 1)) + d >= 0) { const bf16_t* pr = PROJ + (size_t)t * NPROJ + cg;
                      f32x4 ga, gb_, ha, hb; pg8::unpack8(*(const u32x4*)(pr + OFF_GC), ga, gb_); pg8::unpack8(*(const u32x4*)(pr + OFF_HC), ha, hb); ua = ga * ha; ub = gb_ * hb; }
                  if (d >= 0) { const bf16_t* pr = PROJ + (size_t)t * NPROJ + cg; f32x4 ba, bb; pg8::unpack8(*(const u32x4*)(pr + OFF_GB), ba, bb);
                      const f32x4 ca = ba * (w0a * um2a + w1a * um1a + w2a * ua), cb = bb * (w0b * um2b + w1b * um1b + w2b * ub);
                      *(u32x4*)(CI + (size_t)t * DM + cg) = pg8::pack8(ca, cb); }
                  um2a = um1a; um2b = um1b; um1a = ua; um1b = ub; } } }
        if (DBG_P2 & 2) for (int i = gt; i < T * 32; i += NGT) { const int t = i >> 5, f = i & 31; const bf16_t* kp = PROJ + (size_t)t * NPROJ + OFF_KPE;
            const float k1 = __uint_as_float((unsigned)kp[f] << 16), k2 = __uint_as_float((unsigned)kp[f + 32] << 16), c = tab_cos[i], s = tab_sin[i];
            KPE[(size_t)t * DR + f] = (bf16_t)(pk_bf16(k1 * c - k2 * s, 0.f) & 0xffffu); KPE[(size_t)t * DR + f + 32] = (bf16_t)(pk_bf16(k1 * s + k2 * c, 0.f) & 0xffffu); }
        if (DBG_P2 & 4) { pg8::Gemm g{PROJ + OFF_QL, WuqT, NPROJ, QL}; pg8::StaticOrder S; S.init(T, NH * DQK, G, bx);
          pg8::EpiQ E{Qb, ssq_q, tab_cos, tab_sin};
          pg8::gemm_phase<pg8::EpiQ, pg8::StaticOrder, true>(lds, g, S, E); }
        if (DBG_P2 & 8) { pg8::Gemm g{PROJ + OFF_KVL, WkvT, NPROJ, KVL}; pg8::StaticOrder S; S.init(T, 2 * NH * DN, G, bx);
          pg8::EpiKV E{KNb, Vb, ssq_kv};
          pg8::gemm_phase<pg8::EpiKV, pg8::StaticOrder, true>(lds, g, S, E); }
    }
    GRID_BAR(2);

    if (IN(3)) {
        for (int p = vcu; p < BATCH * NH * 8; p += G) { const int bh = p >> 3, s = p & 7;
            _Pragma("nounroll") for (int ui = 0; ui < 2; ++ui) att::attn_unit(bh / NH, bh % NH, ui ? s : 15 - s, Qb, KNb, KPE, Vb, AO, lds); }
    }
    GRID_BAR(3);

    if (IN(4)) {
        static_assert((WS_AO - WS_CI) % (DM * 2) == 0 && (WS_WAB - WS_WCB) % (256 * DM * 2) == 0, "P4 pass offsets");
        pg8::Gemm g{CI, WcbT, DM, DM};
        pg8::PairOrder S; S.nM = T / 256; S.nN = DM / 256; S.nwg = S.nM * S.nN; S.G = G; S.c = bx; S.arow_off1 = (int)((WS_AO - WS_CI) / (DM * 2)); S.pb_off1 = (int)((WS_WAB - WS_WCB) / (256 * DM * 2));
        pg8::EpiGate2 E{YC, MG, PROJ};
        pg8::gemm_phase<pg8::EpiGate2, pg8::PairOrder, true>(lds, g, S, E);
    }
    GRID_BAR(4);

    if (IN(5)) {
        pg8::Gemm g{MG, WoutT, DM, DM}; pg8::StaticOrder S; S.init(T, DM, G, bx);
        pg8::EpiH1 E{H1, x};
        pg8::gemm_phase<pg8::EpiH1, pg8::StaticOrder, true>(lds, g, S, E);
    }
    GRID_BAR(5);

    if (IN(6)) {
        LAS float* Wt = (LAS float*)lds;
        for (int i = tid; i < DM * NE / 4; i += 512) { const int k = i >> 3, q4 = (i & 7) * 4; const f32x4 v = *(const f32x4*)(w_router + (size_t)k * NE + q4);
            Wt[(q4 + 0) * DM + k] = v[0]; Wt[(q4 + 1) * DM + k] = v[1]; Wt[(q4 + 2) * DM + k] = v[2]; Wt[(q4 + 3) * DM + k] = v[3]; }
        LAS unsigned* lhist = (LAS unsigned*)(lds + MISC_OFF + 512); LAS unsigned* lbase = lhist + 32; LAS int* recs = (LAS int*)(lds + MISC_OFF + 768);
        if (tid < 64) lhist[tid] = 0u;
        if (tid < 256) recs[2 * tid] = -1;
        __syncthreads();
        f32x4 gv[4], bv[4];
#pragma unroll
        for (int j = 0; j < 4; ++j) { gv[j] = *(const f32x4*)(ln1_g + 4 * lane + 256 * j); bv[j] = *(const f32x4*)(ln1_b + 4 * lane + 256 * j); }
        const float my_bias = b_router[lane & 31];
        const bool uph = lane >= 32;
        const bool agg = (T / 2 + NGW - 1) / NGW <= 4;
        f32x4 n0[4], n1[4];
        int pr = gw;
        if (pr < T / 2) {
#pragma unroll
            for (int j = 0; j < 4; ++j) { n0[j] = *(const f32x4*)(H1 + (size_t)(2 * pr) * DM + 4 * lane + 256 * j); n1[j] = *(const f32x4*)(H1 + (size_t)(2 * pr + 1) * DM + 4 * lane + 256 * j); } }
        for (int it = 0; pr < T / 2; pr += NGW, ++it) {
            asm volatile("" ::: "memory");
            f32x4 v0[4], v1[4];
#pragma unroll
            for (int j = 0; j < 4; ++j) { v0[j] = n0[j]; v1[j] = n1[j]; }
            { const int pn = pr + NGW;
              if (pn < T / 2) {
#pragma unroll
                for (int j = 0; j < 4; ++j) { n0[j] = *(const f32x4*)(H1 + (size_t)(2 * pn) * DM + 4 * lane + 256 * j); n1[j] = *(const f32x4*)(H1 + (size_t)(2 * pn + 1) * DM + 4 * lane + 256 * j); } } }
            float s0 = 0.f, s1 = 0.f;
#pragma unroll
            for (int j = 0; j < 4; ++j) { s0 += (v0[j][0] + v0[j][1]) + (v0[j][2] + v0[j][3]); s1 += (v1[j][0] + v1[j][1]) + (v1[j][2] + v1[j][3]); }
            float a = (uph ? s1 : s0) + __shfl_xor(uph ? s0 : s1, 32);
#pragma unroll
            for (int o = 16; o >= 1; o >>= 1) a += __shfl_xor(a, o);
            float ot = __shfl_xor(a, 32);
            const float mean0 = (uph ? ot : a) * (1.f / DM), mean1 = (uph ? a : ot) * (1.f / DM);
            s0 = 0.f; s1 = 0.f;
#pragma unroll
            for (int j = 0; j < 4; ++j) { v0[j] = v0[j] - mean0; v1[j] = v1[j] - mean1;
                s0 += (v0[j][0] * v0[j][0] + v0[j][1] * v0[j][1]) + (v0[j][2] * v0[j][2] + v0[j][3] * v0[j][3]);
                s1 += (v1[j][0] * v1[j][0] + v1[j][1] * v1[j][1]) + (v1[j][2] * v1[j][2] + v1[j][3] * v1[j][3]); }
            a = (uph ? s1 : s0) + __shfl_xor(uph ? s0 : s1, 32);
#pragma unroll
            for (int o = 16; o >= 1; o >>= 1) a += __shfl_xor(a, o);
            ot = __shfl_xor(a, 32);
            const float rstd0 = 1.f / sqrtf((uph ? ot : a) * (1.f / DM) + LN_EPS), rstd1 = 1.f / sqrtf((uph ? a : ot) * (1.f / DM) + LN_EPS);
            const size_t t0 = (size_t)(2 * pr);
#pragma unroll
            for (int j = 0; j < 4; ++j) { v0[j] = v0[j] * rstd0 * gv[j] + bv[j]; v1[j] = v1[j] * rstd1 * gv[j] + bv[j];
                *(f32x4*)(X1F + t0 * DM + 4 * lane + 256 * j) = v0[j]; *(f32x4*)(X1F + (t0 + 1) * DM + 4 * lane + 256 * j) = v1[j];
                u32x2 w; w.x = pk_bf16(v0[j][0], v0[j][1]); w.y = pk_bf16(v0[j][2], v0[j][3]); *(u32x2*)(X1B + t0 * DM + 4 * lane + 256 * j) = w;
                w.x = pk_bf16(v1[j][0], v1[j][1]); w.y = pk_bf16(v1[j][2], v1[j][3]); *(u32x2*)(X1B + (t0 + 1) * DM + 4 * lane + 256 * j) = w; }
            f32x2 vv[4][4];
#pragma unroll
            for (int j = 0; j < 4; ++j)
#pragma unroll
                for (int i = 0; i < 4; ++i) vv[j][i] = (f32x2){v0[j][i], v1[j][i]};
            f32x2 p[32];
#pragma unroll
            for (int e = 0; e < 32; ++e) { f32x2 acc = {0.f, 0.f};
#pragma unroll
                for (int j = 0; j < 4; ++j) { const f32x4 w = *(const LAS f32x4*)(Wt + e * DM + 4 * lane + 256 * j);
#pragma unroll
                    for (int i = 0; i < 4; ++i) acc = __builtin_elementwise_fma(vv[j][i], (f32x2){w[i], w[i]}, acc); }
                p[e] = acc; }
            float q[32];
#pragma unroll
            for (int e = 0; e < 32; ++e) q[e] = (uph ? p[e].y : p[e].x) + __shfl_xor(uph ? p[e].x : p[e].y, 32);
#define TRSTEP(W) do { const bool up = (lane & (W)) != 0; _Pragma("unroll") for (int i = 0; i < (W); ++i) { const float mine = up ? q[i + (W)] : q[i], send = up ? q[i] : q[i + (W)]; q[i] = mine + __shfl_xor(send, (W)); } } while (0)
            TRSTEP(16); TRSTEP(8); TRSTEP(4); TRSTEP(2); TRSTEP(1);
#undef TRSTEP
            float lg = q[0] + my_bias;
            int sel[4]; float sv[4];
#pragma unroll
            for (int k = 0; k < 4; ++k) { float m = lg;
                m = fmaxf(m, __builtin_bit_cast(float, __builtin_amdgcn_mov_dpp(__builtin_bit_cast(int, m), 0xB1, 0xf, 0xf, false)));
                m = fmaxf(m, __builtin_bit_cast(float, __builtin_amdgcn_mov_dpp(__builtin_bit_cast(int, m), 0x4E, 0xf, 0xf, false)));
                m = fmaxf(m, __builtin_bit_cast(float, __builtin_amdgcn_mov_dpp(__builtin_bit_cast(int, m), 0x141, 0xf, 0xf, false)));
                m = fmaxf(m, __builtin_bit_cast(float, __builtin_amdgcn_mov_dpp(__builtin_bit_cast(int, m), 0x140, 0xf, 0xf, false)));
                m = fmaxf(m, __shfl_xor(m, 16));
                const unsigned long long bl = __ballot(lg == m); const unsigned hb = uph ? (unsigned)(bl >> 32) : (unsigned)bl;
                const int es = __builtin_ctz(hb | 0x80000000u);
                sel[k] = es; sv[k] = m; lg = ((lane & 31) == es) ? -INFINITY : lg; }
            const float e1 = __expf(sv[1] - sv[0]), e2 = __expf(sv[2] - sv[0]), e3 = __expf(sv[3] - sv[0]); const float inv = 1.f / (1.f + e1 + e2 + e3);
            const int kk = lane & 31;
            if (kk < 4) { const int e = (kk == 0) ? sel[0] : (kk == 1) ? sel[1] : (kk == 2) ? sel[2] : sel[3];
                const float w = ((kk == 0) ? 1.f : (kk == 1) ? e1 : (kk == 2) ? e2 : e3) * inv;
                const size_t t = t0 + (lane >> 5);
                tope[t * 4 + kk] = e; topw[t * 4 + kk] = w;
                if (agg) {
                    const int lpos = (int)__hip_atomic_fetch_add(lhist + e, 1u, __ATOMIC_RELAXED, __HIP_MEMORY_SCOPE_WORKGROUP);
                    const int ri = wave * 32 + it * 8 + (lane >> 5) * 4 + kk; recs[2 * ri] = (int)(t * 4 + kk); recs[2 * ri + 1] = e | (lpos << 8);
                } else {
                    const int pos = (int)__hip_atomic_fetch_add(ecnt + 64 * e, 1u, RLX_AGENT);
                    tpos[t * 4 + kk] = pos; list[(size_t)e * LIST_CAP + pos] = (int)t; } }
        }
        __syncthreads();
        if (agg) {
            if (tid < NE) { const unsigned c = lhist[tid]; lbase[tid] = c ? __hip_atomic_fetch_add(ecnt + 64 * tid, c, RLX_AGENT) : 0u; }
            __syncthreads();
            if (tid < 256) { const int tk = recs[2 * tid];
                if (tk >= 0) { const int el = recs[2 * tid + 1], e = el & 255, pos = (int)lbase[e] + (el >> 8); tpos[tk] = pos; list[(size_t)e * LIST_CAP + pos] = tk >> 2; } }
            __syncthreads();
        }
    }
    GRID_BAR(6);

    if (IN(7) || IN(8) || IN(9)) {
        if (tid < NE) CNT[tid] = (int)__hip_atomic_load(ecnt + 64 * tid, RLX_AGENT);
        __syncthreads();
        if (tid == 0) { int acc = 0; for (int e = 0; e < NE; ++e) { TST[e] = acc; acc += (CNT[e] + 255) >> 8; } TST[NE] = acc; }
        __syncthreads();
    }
    const int nMt = (IN(7) || IN(8) || IN(9)) ? TST[NE] : 0;

    if (IN(7)) {
        pg8::Gemm g{X1B, WguT, DM, DM};
        pg8::MoeOrder<true> S; S.nM = nMt; S.nN = 2 * DFF / 256; S.nwg = S.nM * S.nN; S.G = G; S.c = bx; S.tstart = TST; S.cnt = CNT; S.list = list; S.pf = (LAS int*)(lds + MISC_OFF + 768);
        pg8::EpiGU E{HID, b_gu};
        pg8::gemm_phase<pg8::EpiGU, pg8::MoeOrder<true>, true>(lds, g, S, E);
    }
    GRID_BAR(7);

    if (IN(8)) {
        pg8::Gemm g{HID, WdT, DFF, DFF};
        pg8::MoeOrder<false> S; S.nM = nMt; S.nN = DM / 256; S.nwg = S.nM * S.nN; S.G = G; S.c = bx; S.tstart = TST; S.cnt = CNT; S.list = list; S.pf = nullptr;
        pg8::EpiDown E{EO, b_dn};
        pg8::gemm_phase<pg8::EpiDown, pg8::MoeOrder<false>, true>(lds, g, S, E);
    }
    GRID_BAR(8);

    if (IN(9)) {
        f32x4 gv[4], bv[4];
#pragma unroll
        for (int j = 0; j < 4; ++j) { gv[j] = *(const f32x4*)(ln2_g + 4 * lane + 256 * j); bv[j] = *(const f32x4*)(ln2_b + 4 * lane + 256 * j); }
        for (int t = gw; t < T; t += NGW) {
            int myrow = 0; float myw = 0.f;
            if (lane < 4) { const int e = tope[(size_t)t * 4 + lane]; myrow = TST[e] * 256 + tpos[(size_t)t * 4 + lane]; myw = topw[(size_t)t * 4 + lane]; }
            f32x4 v[4];
#pragma unroll
            for (int j = 0; j < 4; ++j) v[j] = *(const f32x4*)(X1F + (size_t)t * DM + 4 * lane + 256 * j) * DN_ALPHA;
#pragma unroll
            for (int k = 0; k < 4; ++k) { const int row = __builtin_amdgcn_readlane(myrow, k); const float w = __builtin_bit_cast(float, __builtin_amdgcn_readlane(__builtin_bit_cast(int, myw), k));
#pragma unroll
                for (int j = 0; j < 4; ++j) { const u32x2 q = *(const u32x2*)(EO + (size_t)row * DM + 4 * lane + 256 * j);
                    v[j][0] += w * bf_lo(q.x); v[j][1] += w * bf_hi(q.x); v[j][2] += w * bf_lo(q.y); v[j][3] += w * bf_hi(q.y); } }
            float s = 0.f;
#pragma unroll
            for (int j = 0; j < 4; ++j) s += (v[j][0] + v[j][1]) + (v[j][2] + v[j][3]);
            const float mean = wave_sum(s) * (1.f / DM); float s2 = 0.f;
#pragma unroll
            for (int j = 0; j < 4; ++j) { v[j] = v[j] - mean; s2 += (v[j][0] * v[j][0] + v[j][1] * v[j][1]) + (v[j][2] * v[j][2] + v[j][3] * v[j][3]); }
            const float rstd = 1.f / sqrtf(wave_sum(s2) * (1.f / DM) + LN_EPS);
#pragma unroll
            for (int j = 0; j < 4; ++j) *(f32x4*)(out + (size_t)t * DM + 4 * lane + 256 * j) = v[j] * rstd * gv[j] + bv[j];
        }
    }
#if MK_PROBE_PHASE >= 10
    if (IN(11)) { if (bx >= n_gemm1) convert_experts((bx - n_gemm1) * 8 + wave, (G - n_gemm1) * 8, w_gu, w_dn, WguT, WdT, (LAS unsigned*)(lds + wave * 8192), lane); }
    if (IN(12)) { if (bx < n_gemm1) { pg8::Gemm g{XB, WinT, DM, DM}; pg8::StaticOrder S; S.init(T, NPROJ, n_gemm1, bx); pg8::EpiProj E{PROJ, ssq_q, ssq_kv}; pg8::gemm_phase<pg8::EpiProj, pg8::StaticOrder, true>(lds, g, S, E); } }
    if (IN(10)) { pg8::Gemm g{XB, WinT, DM, DM}; pg8::StaticOrder S; S.init(T, NPROJ, G, bx); pg8::EpiNull E{}; pg8::gemm_phase<pg8::EpiNull, pg8::StaticOrder, true>(lds, g, S, E); }
#endif
#undef IN
#undef GRID_BAR
}

extern "C" void kernel_launch(void* const* d_in, const int* in_sizes, int n_in, void* d_out, int out_size, void* d_ws, size_t ws_size, hipStream_t stream) {
    static int grid = 0;
    if (grid == 0) {
        if (n_in != 22 || in_sizes[0] != T * DM || out_size != T * DM || ws_size < WS_END) {
            fprintf(stderr, "kernel_launch: shape mismatch: n_in %d in0 %d out %d ws %zu (need %zu)\n", n_in, n_in > 0 ? in_sizes[0] : -1, out_size, ws_size, (size_t)WS_END); grid = -1; return; }
        int dev = 0, cus = 0, per_cu = 0;
        if (hipGetDevice(&dev) != hipSuccess || hipDeviceGetAttribute(&cus, hipDeviceAttributeMultiprocessorCount, dev) != hipSuccess) { fprintf(stderr, "kernel_launch: device query failed\n"); grid = -1; return; }
        if (hipFuncSetAttribute((const void*)mk_fwd, hipFuncAttributeMaxDynamicSharedMemorySize, LDS_BYTES) != hipSuccess) { fprintf(stderr, "kernel_launch: hipFuncSetAttribute failed\n"); grid = -1; return; }
        if (hipOccupancyMaxActiveBlocksPerMultiprocessor(&per_cu, (const void*)mk_fwd, 512, LDS_BYTES) != hipSuccess || per_cu < 1) {
            fprintf(stderr, "kernel_launch: occupancy query reports %d blocks per CU\n", per_cu); (void)hipGetLastError(); grid = -1; return; }
        (void)hipGetLastError();
        grid = cus;
    }
    if (grid < 0) return;
    if (hipMemsetAsync((char*)d_ws + WS_CTL, 0, CTL_ZERO_BYTES, stream) != hipSuccess) { fprintf(stderr, "kernel_launch: memset failed\n"); return; }
    Args a{};
    for (int i = 0; i < 22; ++i) a.in[i] = d_in[i];
    a.out = (float*)d_out; a.ws = (unsigned char*)d_ws;
    for (int li = 0; li < N_LAUNCHES; ++li) {
        a.ph_lo = (N_LAUNCHES == 1) ? 0 : li; a.ph_hi = (N_LAUNCHES == 1) ? N_PHASES : li + 1;
        hipLaunchKernelGGL(mk_fwd, dim3(grid), dim3(512), LDS_BYTES, stream, a);
        const hipError_t le = hipPeekAtLastError();
        if (le != hipSuccess) { fprintf(stderr, "kernel_launch: launch %d failed: %s\n", li, hipGetErrorName(le)); break; }
    }
    if (MK_PROBE_PHASE >= 0) {
        a.ph_lo = MK_PROBE_PHASE; a.ph_hi = MK_PROBE_PHASE + 1;
        hipLaunchKernelGGL(mk_fwd, dim3(grid), dim3(512), LDS_BYTES, stream, a);
    }
}
```
